# Optimizing an MI355X kernel written in HIP

```python
import math
import jax, jax.numpy as jnp
from jax import lax
import numpy as np

D_MODEL = 1024
BATCH = 16
SEQ = 2048
DEPTH = 1

CHUNK = 64
PLE_DIM = 256
POOL_WIDTH = D_MODEL
POOL_WINDOWS = (2, 4, 8, 16)
N_POOL_GROUPS = 4
POOL_GROUP = POOL_WIDTH // N_POOL_GROUPS
SSM_WIDTH = D_MODEL // 2
SSM_GROUP_CH = 16
SSM_GROUPS = SSM_WIDTH // SSM_GROUP_CH
SSM_STATE = 64
DT_MIN = 1e-3
DT_MAX = 1e-1
LN_EPS = 1e-5
DEEPNORM_ALPHA = (2.0 * DEPTH) ** 0.25
DEEPNORM_BETA = (8.0 * DEPTH) ** -0.25
SPLIT_POINTS = (
    POOL_WIDTH,
    2 * POOL_WIDTH,
    2 * POOL_WIDTH + SSM_WIDTH,
    2 * POOL_WIDTH + 2 * SSM_WIDTH,
    2 * POOL_WIDTH + 2 * SSM_WIDTH + D_MODEL,
    2 * POOL_WIDTH + 2 * SSM_WIDTH + 2 * D_MODEL,
)
IN_WIDTH = 2 * POOL_WIDTH + 2 * SSM_WIDTH + 3 * D_MODEL

kernel_name = "hybrid_pool_s5_gated_deepnorm"


def layer_norm(x, g, b):
    x32 = x.astype(jnp.float32)
    mu = jnp.mean(x32, axis=-1, keepdims=True)
    var = jnp.mean(jnp.square(x32 - mu), axis=-1, keepdims=True)
    y = (x32 - mu) * lax.rsqrt(var + LN_EPS)
    return (y * g.astype(jnp.float32) + b.astype(jnp.float32)).astype(x.dtype)


def pool_mixer(u, w_groups, scale):
    bsz, s, _ = u.shape
    ug = u.astype(jnp.float32).reshape(bsz, s, N_POOL_GROUPS, POOL_GROUP)
    cs = jnp.cumsum(ug, axis=1)
    t = jnp.arange(s)
    outs = []
    for gi, w in enumerate(POOL_WINDOWS):
        c = cs[:, :, gi, :]
        prev = jnp.pad(c, ((0, 0), (w, 0), (0, 0)))[:, :s]
        cnt = jnp.minimum(t + 1, w).astype(jnp.float32)[None, :, None]
        outs.append((c - prev) / cnt - ug[:, :, gi, :])
    d = jnp.stack(outs, axis=2).astype(u.dtype)
    y = jnp.einsum("bsgi,gio->bsgo", d, w_groups).reshape(bsz, s, POOL_WIDTH)
    return y * scale


def cmul(ar, ai, br, bi):
    return ar * br - ai * bi, ar * bi + ai * br


def s5_mixer(u, a_re, a_im, log_dt, b_re, b_im, c_re, c_im, d_skip, glu_w, glu_b):
    bsz, s, _ = u.shape
    f32 = jnp.float32
    u32 = u.astype(f32).reshape(bsz, s, SSM_GROUPS, SSM_GROUP_CH)
    dt = jnp.exp(log_dt.astype(f32))[:, None]
    lr = a_re.astype(f32)
    li = a_im.astype(f32)
    mag = jnp.exp(lr * dt)
    abar_r = mag * jnp.cos(li * dt)
    abar_i = mag * jnp.sin(li * dt)
    den = lr * lr + li * li
    zr, zi = cmul(abar_r - 1.0, abar_i, lr, -li)
    zr = zr / den
    zi = zi / den
    bbar_r, bbar_i = cmul(zr[..., None], zi[..., None], b_re.astype(f32), b_im.astype(f32))
    bu_r = jnp.einsum("bsgh,gph->sbgp", u32, bbar_r)
    bu_i = jnp.einsum("bsgh,gph->sbgp", u32, bbar_i)
    a_r = jnp.broadcast_to(abar_r[None, None], (s, 1, SSM_GROUPS, SSM_STATE))
    a_i = jnp.broadcast_to(abar_i[None, None], (s, 1, SSM_GROUPS, SSM_STATE))

    def combine(left, right):
        al_r, al_i, bl_r, bl_i = left
        ar_r, ar_i, br_r, br_i = right
        na_r, na_i = cmul(ar_r, ar_i, al_r, al_i)
        t_r, t_i = cmul(ar_r, ar_i, bl_r, bl_i)
        return na_r, na_i, t_r + br_r, t_i + br_i

    _, _, xr, xi = lax.associative_scan(combine, (a_r, a_i, bu_r, bu_i), axis=0)
    y = (jnp.einsum("sbgp,ghp->bsgh", xr, c_re.astype(f32))
         - jnp.einsum("sbgp,ghp->bsgh", xi, c_im.astype(f32)))
    y = y.reshape(bsz, s, SSM_WIDTH) + d_skip.astype(f32) * u32.reshape(bsz, s, SSM_WIDTH)
    g = jax.nn.gelu(y)
    out = g * jax.nn.sigmoid(g @ glu_w.astype(f32) + glu_b.astype(f32))
    return out.astype(u.dtype)


def setup_inputs(seed: int = 0) -> dict:
    key = jax.random.key(seed)
    ks = jax.random.split(key, 24)
    f32 = jnp.float32
    L = DEPTH
    nrm = lambda k, shape: jax.random.normal(k, shape, f32)
    x = nrm(ks[0], (BATCH, SEQ, D_MODEL))
    p = nrm(ks[1], (DEPTH, BATCH, SEQ, PLE_DIM))
    w_in = nrm(ks[2], (L, D_MODEL, IN_WIDTH)) * D_MODEL ** -0.5
    pool_w = nrm(ks[3], (L, N_POOL_GROUPS, POOL_GROUP, POOL_GROUP)) * POOL_GROUP ** -0.5
    pool_scale = 1.0 + 0.02 * nrm(ks[4], (L, POOL_WIDTH))
    n = jnp.arange(SSM_STATE, dtype=f32)
    ssm_a_re = -0.5 + 0.01 * nrm(ks[5], (L, SSM_GROUPS, SSM_STATE))
    ssm_a_im = math.pi * n[None, None, :] + 0.01 * nrm(ks[6], (L, SSM_GROUPS, SSM_STATE))
    ssm_log_dt = (math.log(DT_MIN) + jax.random.uniform(ks[7], (L, SSM_GROUPS), f32)
                  * (math.log(DT_MAX) - math.log(DT_MIN)))
    b_std = (2.0 * SSM_GROUP_CH) ** -0.5
    ssm_b_re = nrm(ks[8], (L, SSM_GROUPS, SSM_STATE, SSM_GROUP_CH)) * b_std
    ssm_b_im = nrm(ks[9], (L, SSM_GROUPS, SSM_STATE, SSM_GROUP_CH)) * b_std
    c_std = (2.0 * SSM_STATE) ** -0.5
    ssm_c_re = nrm(ks[10], (L, SSM_GROUPS, SSM_GROUP_CH, SSM_STATE)) * c_std
    ssm_c_im = nrm(ks[11], (L, SSM_GROUPS, SSM_GROUP_CH, SSM_STATE)) * c_std
    ssm_d = nrm(ks[12], (L, SSM_WIDTH))
    glu_w = nrm(ks[13], (L, SSM_WIDTH, SSM_WIDTH)) * SSM_WIDTH ** -0.5
    glu_b = 0.01 * nrm(ks[14], (L, SSM_WIDTH))
    w_branch_pool = nrm(ks[15], (L, POOL_WIDTH, D_MODEL)) * POOL_WIDTH ** -0.5 * DEEPNORM_BETA
    w_branch_ssm = nrm(ks[16], (L, SSM_WIDTH, D_MODEL)) * SSM_WIDTH ** -0.5 * DEEPNORM_BETA
    w_out = nrm(ks[17], (L, D_MODEL, D_MODEL)) * D_MODEL ** -0.5 * DEEPNORM_BETA
    w_ple = nrm(ks[18], (L, PLE_DIM, D_MODEL)) * PLE_DIM ** -0.5 * DEEPNORM_BETA
    ln_g = 1.0 + 0.02 * nrm(ks[19], (L, D_MODEL))
    ln_b = 0.01 * nrm(ks[20], (L, D_MODEL))
    return {"x": x, "p": p, "w_in": w_in, "pool_w": pool_w, "pool_scale": pool_scale,
            "ssm_a_re": ssm_a_re, "ssm_a_im": ssm_a_im, "ssm_log_dt": ssm_log_dt,
            "ssm_b_re": ssm_b_re, "ssm_b_im": ssm_b_im, "ssm_c_re": ssm_c_re, "ssm_c_im": ssm_c_im,
            "ssm_d": ssm_d, "glu_w": glu_w, "glu_b": glu_b,
            "w_branch_pool": w_branch_pool, "w_branch_ssm": w_branch_ssm, "w_out": w_out,
            "w_ple": w_ple, "ln_g": ln_g, "ln_b": ln_b}


def reference(x, p, w_in, pool_w, pool_scale, ssm_a_re, ssm_a_im, ssm_log_dt,
              ssm_b_re, ssm_b_im, ssm_c_re, ssm_c_im, ssm_d, glu_w, glu_b,
              w_branch_pool, w_branch_ssm, w_out, w_ple, ln_g, ln_b):
    for i in range(DEPTH):
        proj = jnp.einsum("bsd,dn->bsn", x, w_in[i])
        pool_in, pool_gate, ssm_in, ssm_gate, g_pool, g_ssm, ple_gate = jnp.split(
            proj, SPLIT_POINTS, axis=-1)
        y_pool = pool_mixer(pool_in, pool_w[i], pool_scale[i]) * jax.nn.silu(pool_gate)
        y_ssm = s5_mixer(ssm_in, ssm_a_re[i], ssm_a_im[i], ssm_log_dt[i], ssm_b_re[i],
                         ssm_b_im[i], ssm_c_re[i], ssm_c_im[i], ssm_d[i], glu_w[i],
                         glu_b[i]) * jax.nn.silu(ssm_gate)
        merged = (jax.nn.sigmoid(g_pool) * (y_pool @ w_branch_pool[i])
                  + jax.nn.sigmoid(g_ssm) * (y_ssm @ w_branch_ssm[i]))
        mix = merged @ w_out[i]
        ple = jax.nn.sigmoid(ple_gate) * (p[i] @ w_ple[i])
        x = layer_norm(DEEPNORM_ALPHA * x + mix + ple, ln_g[i], ln_b[i])
    return x
```

```cpp
#include <hip/hip_runtime.h>
#include <hip/hip_cooperative_groups.h>
#include <cstdio>
namespace cg = cooperative_groups;

#define LAS __attribute__((address_space(3)))
typedef unsigned short bf16_t;
typedef short bf16x8 __attribute__((ext_vector_type(8)));
typedef float f32x4 __attribute__((ext_vector_type(4)));
typedef float f32x2 __attribute__((ext_vector_type(2)));
typedef unsigned u32x4 __attribute__((ext_vector_type(4)));

constexpr int T = 32768;
constexpr int NTHR = 512;
constexpr int LDS_STAGE = 131072;
constexpr int LDS_BYTES = LDS_STAGE + 64;
constexpr float ALPHA = 1.189207115002721f;
constexpr float LN_EPS = 1e-5f;

constexpr size_t SZ_XB = (size_t)T * 1024 * 2;
constexpr size_t SZ_YY = (size_t)T * 1536 * 2;
constexpr size_t SZ_A6 = (size_t)T * 1280 * 2;
constexpr size_t SZ_PG = (size_t)T * 1024 * 2;
constexpr size_t SZ_UA = (size_t)32 * 1024 * 640 * 2;
constexpr size_t SZ_WT1 = (size_t)6144 * 1024 * 2;
constexpr size_t SZ_WINP = (size_t)1024 * 1024 * 2;
constexpr size_t SZ_PWT = (size_t)256 * 1024 * 2;
constexpr size_t SZ_GLT = (size_t)512 * 512 * 2;
constexpr size_t SZ_W5 = (size_t)1024 * 1536 * 2;
constexpr size_t SZ_W6 = (size_t)1024 * 1280 * 2;
constexpr size_t SZ_WT2 = (size_t)32 * 256 * 512 * 2;
constexpr size_t SZ_BT3 = (size_t)32 * 512 * 640 * 2;
constexpr size_t SZ_KTAB = (size_t)32 * 32 * 256 * 4;
constexpr size_t SZ_AL = (size_t)32 * 64 * 8;
constexpr size_t SZ_STATS = (size_t)T * 16 * 8;
constexpr size_t OFF_XB = 0;
constexpr size_t OFF_YY = OFF_XB + SZ_XB;
constexpr size_t OFF_A6 = OFF_YY + SZ_YY;
constexpr size_t OFF_PG = OFF_A6 + SZ_A6;
constexpr size_t OFF_UA = OFF_PG + SZ_PG;
constexpr size_t OFF_WT1 = OFF_UA + SZ_UA;
constexpr size_t OFF_WINP = OFF_WT1 + SZ_WT1;
constexpr size_t OFF_PWT = OFF_WINP + SZ_WINP;
constexpr size_t OFF_GLT = OFF_PWT + SZ_PWT;
constexpr size_t OFF_W5 = OFF_GLT + SZ_GLT;
constexpr size_t OFF_W6 = OFF_W5 + SZ_W5;
constexpr size_t OFF_WT2 = OFF_W6 + SZ_W6;
constexpr size_t OFF_BT3 = OFF_WT2 + SZ_WT2;
constexpr size_t OFF_KTAB = OFF_BT3 + SZ_BT3;
constexpr size_t OFF_AL = OFF_KTAB + SZ_KTAB;
constexpr size_t OFF_STATS = OFF_AL + SZ_AL;
constexpr size_t OFF_CTL = OFF_STATS + SZ_STATS;
constexpr size_t SZ_CTL = 65536;
constexpr size_t WS_END = OFF_CTL + SZ_CTL;

struct Params { const float* in[21]; float* out; unsigned char* ws; };

__device__ __forceinline__ int tid_local() { int t = threadIdx.x; asm volatile("" : "+v"(t)); return t; }
__device__ __forceinline__ unsigned cvt_pk_bf16(float lo, float hi) { unsigned r; asm("v_cvt_pk_bf16_f32 %0, %1, %2" : "=v"(r) : "v"(lo), "v"(hi)); return r; }
__device__ __forceinline__ u32x4 pack8(f32x4 a, f32x4 b) { u32x4 w; w.x = cvt_pk_bf16(a[0], a[1]); w.y = cvt_pk_bf16(a[2], a[3]); w.z = cvt_pk_bf16(b[0], b[1]); w.w = cvt_pk_bf16(b[2], b[3]); return w; }
__device__ __forceinline__ void unpack8(u32x4 w, f32x4& a, f32x4& b) {
    a[0] = __uint_as_float(w.x << 16); a[1] = __uint_as_float(w.x & 0xffff0000u); a[2] = __uint_as_float(w.y << 16); a[3] = __uint_as_float(w.y & 0xffff0000u);
    b[0] = __uint_as_float(w.z << 16); b[1] = __uint_as_float(w.z & 0xffff0000u); b[2] = __uint_as_float(w.w << 16); b[3] = __uint_as_float(w.w & 0xffff0000u); }
__device__ __forceinline__ float sigm(float x) { return __builtin_amdgcn_rcpf(1.0f + __expf(-x)); }
__device__ __forceinline__ f32x4 sigm4(f32x4 v) { f32x4 r; r[0] = sigm(v[0]); r[1] = sigm(v[1]); r[2] = sigm(v[2]); r[3] = sigm(v[3]); return r; }
__device__ __forceinline__ f32x4 gelu4(f32x4 v) {
    const f32x4 u = v * ((v * v) * (-0.10294324f) + (-2.3022082f)); f32x4 r;
#pragma unroll
    for (int e = 0; e < 4; ++e) r[e] = v[e] * __builtin_amdgcn_rcpf(1.0f + __builtin_amdgcn_exp2f(u[e]));
    return r; }


#define XB_TMO      128
#define XB_XCNT(j)  (256  + 64 * (j))
#define XB_XSUB(j)  (1280 + 64 * (j))
#define XB_XGEN(j)  (2304 + 64 * (j))
#define XB_TOP      3328
#define XB_TOPGEN   3392
#define XCD_BAR_WORDS 3456
#define XB_SPIN_CAP (1u << 22)
__device__ __forceinline__ unsigned xb_ld(unsigned* p)              { return __hip_atomic_load(p, __ATOMIC_RELAXED, __HIP_MEMORY_SCOPE_AGENT); }
__device__ __forceinline__ unsigned xb_add(unsigned* p, unsigned v) { return __hip_atomic_fetch_add(p, v, __ATOMIC_RELAXED, __HIP_MEMORY_SCOPE_AGENT); }
__device__ __forceinline__ unsigned xb_xcc_id() { return (unsigned)__builtin_amdgcn_s_getreg((3 << 11) | 20) & 0xFu; }
#define XB_SPIN(cond, bar) do { unsigned _sp = 0; while (cond) { __builtin_amdgcn_s_sleep(1); \
    if ((++_sp & 255u) == 0u) { if (xb_ld(&(bar)[XB_TMO])) break; if (_sp > XB_SPIN_CAP) { atomicAdd(&(bar)[XB_TMO], 1u); break; } } } } while (0)
struct XcdBarrier { unsigned* bar; unsigned x; volatile LAS unsigned* st; };
__device__ __forceinline__ XcdBarrier xcd_barrier_post(unsigned* bar, volatile LAS unsigned* st) {
    XcdBarrier b; b.bar = bar; b.x = xb_xcc_id(); b.st = st;
    if (threadIdx.x == 0) (void)xb_add(&bar[XB_XCNT(b.x)], 1u);
    return b;
}
__device__ __forceinline__ void xcd_barrier_complete(unsigned* bar, unsigned x, unsigned& nloc, unsigned& nx) {
    const unsigned G = gridDim.x * gridDim.y * gridDim.z;
    unsigned sum, cnt, mine, sp = 0u;
    for (;;) {
        sum = 0u; cnt = 0u; mine = 0u;
#pragma unroll
        for (unsigned j = 0; j < 16; ++j) { const unsigned c = xb_ld(&bar[XB_XCNT(j)]); sum += c; cnt += (c > 0u) ? 1u : 0u; mine = (j == x) ? c : mine; }
        if (sum == G) break;
        __builtin_amdgcn_s_sleep(1);
        if ((++sp & 255u) == 0u) { if (xb_ld(&bar[XB_TMO])) break; if (sp > XB_SPIN_CAP) { atomicAdd(&bar[XB_TMO], 1u); break; } }
    }
    nloc = mine > 0u ? mine : 1u; nx = cnt > 0u ? cnt : 1u;
}
__device__ __forceinline__ void xcd_barrier(const XcdBarrier& b) {
    asm volatile("s_waitcnt vmcnt(0)" ::: "memory");
    __syncthreads();
    if (threadIdx.x == 0) {
        unsigned* bar = b.bar;
        __builtin_amdgcn_s_waitcnt(0);
        unsigned nloc = b.st[0], nx = b.st[1];
        if (nloc == 0u) { xcd_barrier_complete(bar, b.x, nloc, nx); b.st[0] = nloc; b.st[1] = nx; }
        const unsigned old = xb_add(&bar[XB_XSUB(b.x)], 1u);
        const unsigned gen = old / nloc;
        if (old + 1u == (gen + 1u) * nloc) {
            __builtin_amdgcn_fence(__ATOMIC_RELEASE, "agent");
            asm volatile("s_waitcnt vmcnt(0)" ::: "memory");
            const unsigned og = xb_add(&bar[XB_TOP], 1u);
            const unsigned tg = og / nx;
            if (og + 1u == (tg + 1u) * nx) xb_add(&bar[XB_TOPGEN], 1u);
            else XB_SPIN(xb_ld(&bar[XB_TOPGEN]) == tg, bar);
            __builtin_amdgcn_fence(__ATOMIC_ACQUIRE, "agent");
            xb_add(&bar[XB_XGEN(b.x)], 1u);
            asm volatile("s_waitcnt vmcnt(0)" ::: "memory");
        } else {
            XB_SPIN(xb_ld(&bar[XB_XGEN(b.x)]) == gen, bar);
            __builtin_amdgcn_fence(__ATOMIC_ACQUIRE, "agent");
            asm volatile("s_waitcnt vmcnt(0)" ::: "memory");
        }
    }
    __syncthreads();
}

namespace pg8 {
constexpr int BM = 256, BK = 64, HALF = 128, HTB = HALF * BK * 2, NXCD = 8, WGM = 8;
__device__ __forceinline__ int lds_byte(int r, int c) { const int st = (r >> 4) * 2 + (c >> 5), rr = r & 15, cc = c & 31, ob = rr * 64 + cc * 2; return st * 1024 + (ob ^ (((ob >> 9) & 1) << 5)); }
__device__ __forceinline__ void stage_rc(int b, int& R, int& C) { const int st = b / 1024, sb = b % 1024, swz = sb ^ (((sb >> 9) & 1) << 5); R = (st >> 1) * 16 + swz / 64; C = (st & 1) * 32 + (swz % 64) / 2; }
__device__ __forceinline__ int perm32(int rho) { const int n = rho >> 4, i = rho & 15; return 8 * (i >> 2) + 4 * n + (i & 3); }

struct Seg { const char* A; const char* B; int nt, fin, pm, pn, g; };

struct Sched {
    const char* A; const char* B; size_t gsA, gsB;
    int lda, ldb;
    int nM, nN, nG;
    int nseg, ka0, kb0, nt0, ka1, kb1, nt1;
    int G, c, mode;
    int ui0 = 0, nui = 1 << 30;
    __device__ __forceinline__ bool next(int i, Seg& s) const {
        const int ur = (nseg == 2) ? (i >> 1) : i, si = (nseg == 2) ? (i & 1) : 0; if (ur >= nui) return false; const int ui = ui0 + ur;
        const int nwg = nM * nN * nG; const long L = (long)ui * G + c; if (L >= nwg) return false;
        int g = 0, pm, pn;
        if (mode == 0) {
            int wgid = (int)L; { const int q = nwg / NXCD, r = nwg % NXCD, xcd = wgid % NXCD, off = wgid / NXCD; wgid = (xcd < r ? xcd * (q + 1) : r * (q + 1) + (xcd - r) * q) + off; }
            const int nig = WGM * nN, gid = wgid / nig, fm = gid * WGM, gsz = (nM - fm) < WGM ? (nM - fm) : WGM;
            pm = fm + ((wgid % nig) % gsz); pn = (wgid % nig) / gsz;
        } else { const int per = nM * nN; g = (int)L / per; const int rem = (int)L % per; pm = rem / nN; pn = rem % nN; }
        const int ka = si ? ka1 : ka0, kb = si ? kb1 : kb0;
        s.A = A + (size_t)g * gsA + ((size_t)pm * BM * lda + ka) * 2; s.B = B + (size_t)g * gsB + ((size_t)pn * BM * ldb + kb) * 2;
        s.nt = si ? nt1 : nt0; s.fin = (si == nseg - 1) ? 1 : 0; s.pm = pm; s.pn = pn; s.g = g; return true;
    }
};

typedef f32x4 Acc[2][2][4][2];
#define EPI_ROWS(s) _Pragma("unroll") for (int ai = 0; ai < 2; ++ai) _Pragma("unroll") for (int m = 0; m < 4; ++m)
#define EPI_FENCE() do { if (m == 3) asm volatile("" ::: "memory"); } while (0)
#define EPI_R(s) ((s).pm * 256 + ai * 128 + wr * 64 + m * 16 + fr)
#define EPI_C(s, bj) ((s).pn * 256 + wc * 64 + (bj) * 32 + fq * 8)

template <class Epi>
__device__ __forceinline__ void gemm_phase(LAS unsigned char* lds, const Sched& S, const Epi& E) {
    const int tid = tid_local(), wid = __builtin_amdgcn_readfirstlane(tid >> 6), lane = tid & 63, wr = wid >> 2, wc = wid & 3, fr = lane & 15, fq = lane >> 4;
    const int lda = S.lda, ldb = S.ldb;
    unsigned voffA[2], voffB[2];
#pragma unroll
    for (int i = 0; i < 2; ++i) { int R, C; stage_rc(tid * 16 + i * 8192, R, C); const int Rb = (R >> 5) * 64 + perm32(R & 31);
        voffA[i] = (unsigned)(R * lda + C) * 2u; voffB[i] = (unsigned)(Rb * ldb + C) * 2u; }
    const size_t kstep = (size_t)(BK * 2);
    const size_t hstepA = (size_t)HALF * lda * 2, hstepB = (size_t)32 * ldb * 2;
    const unsigned ldsw = (unsigned)wid * 1024u;
    const int aoff = lds_byte(wr * 64 + fr, fq * 8), boff = lds_byte(wc * 32 + fr, fq * 8);
#define PG8_SA(b, h) (((b) * 2 + (h)) * HTB)
#define PG8_SB(b, h) ((4 + (b) * 2 + (h)) * HTB)
#define PG8_STAGE(bufoff, gbase, voff) do { _Pragma("unroll") for (int _i = 0; _i < 2; ++_i) \
        __builtin_amdgcn_global_load_lds((const unsigned*)((const char*)(gbase) + (voff)[_i]), (LAS unsigned*)(lds + (bufoff) + ldsw + _i * 8192), 16, 0, 0); } while (0)
#define PG8_LDA(dst, b, h) do { _Pragma("unroll") for (int m = 0; m < 4; ++m) _Pragma("unroll") for (int k = 0; k < 2; ++k) dst[m][k] = *(const LAS bf16x8*)(lds + PG8_SA(b, h) + aoff + m * 2048 + k * 1024); } while (0)
#define PG8_LDB(dst, b, h) do { _Pragma("unroll") for (int n = 0; n < 2; ++n) _Pragma("unroll") for (int k = 0; k < 2; ++k) dst[n][k] = *(const LAS bf16x8*)(lds + PG8_SB(b, h) + boff + n * 2048 + k * 1024); } while (0)
#define PG8_MMA(ai, bj, At, Bt) do { __builtin_amdgcn_s_setprio(1); _Pragma("unroll") for (int m = 0; m < 4; ++m) _Pragma("unroll") for (int n = 0; n < 2; ++n) _Pragma("unroll") for (int k = 0; k < 2; ++k) \
        acc[ai][bj][m][n] = __builtin_amdgcn_mfma_f32_16x16x32_bf16(Bt[n][k], At[m][k], acc[ai][bj][m][n], 0, 0, 0); __builtin_amdgcn_s_setprio(0); } while (0)
#define PG8_WAIT_V(n) asm volatile("s_waitcnt vmcnt(" #n ")" ::: "memory")
#define PG8_WAIT_L(n) asm volatile("s_waitcnt lgkmcnt(" #n ")" ::: "memory")
#define PG8_BAR __builtin_amdgcn_s_barrier()
#define PG8_SCHED __builtin_amdgcn_sched_barrier(0)
#define PG8_ZERO() do { _Pragma("unroll") for (int a = 0; a < 2; ++a) _Pragma("unroll") for (int b = 0; b < 2; ++b) _Pragma("unroll") for (int m = 0; m < 4; ++m) _Pragma("unroll") for (int n = 0; n < 2; ++n) acc[a][b][m][n] = (f32x4){0.f, 0.f, 0.f, 0.f}; } while (0)
    Seg cur, nxt; int ui = 0;
    if (!S.next(0, cur)) return;
    Acc acc;
    PG8_ZERO();
    bf16x8 At[4][2], B0[2][2], B1[2][2];
    const char* cA = cur.A; const char* cB = cur.B; int nt = cur.nt;
    PG8_STAGE(PG8_SB(0, 0), cB, voffB); PG8_STAGE(PG8_SA(0, 0), cA, voffA); PG8_STAGE(PG8_SB(0, 1), cB + hstepB, voffB); PG8_STAGE(PG8_SA(0, 1), cA + hstepA, voffA);
    if (wr == 1) PG8_BAR;
    PG8_WAIT_V(4); PG8_BAR;
    PG8_STAGE(PG8_SB(1, 0), cB + kstep, voffB); PG8_STAGE(PG8_SA(1, 0), cA + kstep, voffA); PG8_STAGE(PG8_SB(1, 1), cB + hstepB + kstep, voffB);
    PG8_WAIT_V(6); PG8_BAR;
    for (;;) {
        const bool has_next = S.next(ui + 1, nxt);
        const char* nA = has_next ? nxt.A : cA; const char* nB = has_next ? nxt.B : cB;
        for (int t = 0; t < nt; t += 2) {
            const bool last = (t == nt - 2);
            const char* a1 = cA + (size_t)(t + 1) * kstep;
            const char* a2 = last ? nA : cA + (size_t)(t + 2) * kstep; const char* b2 = last ? nB : cB + (size_t)(t + 2) * kstep;
            const char* a3 = a2 + kstep; const char* b3 = b2 + kstep;
            PG8_LDB(B0, 0, 0); PG8_SCHED; PG8_LDA(At, 0, 0); PG8_STAGE(PG8_SA(1, 1), a1 + hstepA, voffA);
            PG8_WAIT_L(8); PG8_BAR; PG8_WAIT_L(0); PG8_MMA(0, 0, At, B0); PG8_BAR; PG8_SCHED;
            PG8_LDB(B1, 0, 1); PG8_STAGE(PG8_SB(0, 0), b2, voffB);
            PG8_BAR; PG8_WAIT_L(0); PG8_MMA(0, 1, At, B1); PG8_BAR;
            PG8_LDA(At, 0, 1); PG8_STAGE(PG8_SA(0, 0), a2, voffA);
            PG8_BAR; PG8_WAIT_L(0); PG8_MMA(1, 0, At, B0); PG8_BAR; PG8_SCHED;
            PG8_STAGE(PG8_SB(0, 1), b2 + hstepB, voffB);
            PG8_WAIT_V(6); PG8_BAR; PG8_MMA(1, 1, At, B1); PG8_BAR;
            PG8_LDB(B0, 1, 0); PG8_SCHED; PG8_LDA(At, 1, 0); PG8_STAGE(PG8_SA(0, 1), a2 + hstepA, voffA);
            PG8_WAIT_L(8); PG8_BAR; PG8_WAIT_L(0); PG8_MMA(0, 0, At, B0); PG8_BAR; PG8_SCHED;
            PG8_LDB(B1, 1, 1); PG8_STAGE(PG8_SB(1, 0), b3, voffB);
            PG8_BAR; PG8_WAIT_L(0); PG8_MMA(0, 1, At, B1); PG8_BAR;
            PG8_LDA(At, 1, 1); PG8_STAGE(PG8_SA(1, 0), a3, voffA);
            PG8_BAR; PG8_WAIT_L(0); PG8_MMA(1, 0, At, B0); PG8_BAR; PG8_SCHED;
            PG8_STAGE(PG8_SB(1, 1), b3 + hstepB, voffB);
            PG8_WAIT_V(6); PG8_BAR; PG8_MMA(1, 1, At, B1); PG8_BAR;
        }
        if (cur.fin) { if constexpr (!Epi::AFTER_DRAIN) E.fin(acc, cur, wr, wc, fr, fq); }
        else E.mid(acc, cur, wr, wc, fr, fq);
        if (!has_next) break;
        if (cur.fin) PG8_ZERO();
        cur = nxt; cA = nA; cB = nB; nt = cur.nt; ++ui;
    }
    PG8_WAIT_V(0);
    if (wr == 0) PG8_BAR;
    PG8_BAR;
    if constexpr (Epi::AFTER_DRAIN) E.fused(acc, cur, wr, wc, fr, fq, lds);
#undef PG8_SA
#undef PG8_SB
#undef PG8_STAGE
#undef PG8_LDA
#undef PG8_LDB
#undef PG8_MMA
#undef PG8_WAIT_V
#undef PG8_WAIT_L
#undef PG8_BAR
#undef PG8_SCHED
#undef PG8_ZERO
}

struct EpiFold {
    static constexpr bool AFTER_DRAIN = false;
    bf16_t* WT1;
    __device__ __forceinline__ void mid(Acc&, const Seg&, int, int, int, int) const {}
    __device__ __forceinline__ void fin(Acc& acc, const Seg& s, int wr, int wc, int fr, int fq) const {
        EPI_ROWS(s) { const int r = EPI_R(s);
#pragma unroll
            for (int bj = 0; bj < 2; ++bj) { const int c = EPI_C(s, bj); *(u32x4*)(WT1 + (size_t)(s.g * 256 + r) * 1024 + c) = pack8(acc[ai][bj][m][0], acc[ai][bj][m][1]); } }
    }
};
struct EpiProj {
    static constexpr bool AFTER_DRAIN = false;
    bf16_t *Z, *YY, *UA, *A6, *GS, *PG;
    __device__ __forceinline__ void mid(Acc&, const Seg&, int, int, int, int) const {}
    __device__ __forceinline__ void fin(Acc& acc, const Seg& s, int wr, int wc, int fr, int fq) const {
        const int pn = s.pn;
        if (pn == 8 || pn == 9) {
            EPI_ROWS(s) { const int r = EPI_R(s);
#pragma unroll
                for (int bj = 0; bj < 2; ++bj) { const int c = (pn - 8) * 256 + wc * 64 + bj * 32 + fq * 8; const int g = c >> 4, h0 = c & 15;
                    __builtin_nontemporal_store(pack8(acc[ai][bj][m][0], acc[ai][bj][m][1]), (u32x4*)(UA + (size_t)g * (1024 * 640) + (size_t)(r >> 5) * 640 + (r & 31) * 16 + h0)); } }
            return;
        }
        if (pn >= 12 && pn < 20) {
            const int cp = (pn - 12) * 128 + wc * 32 + fq * 8;
            EPI_ROWS(s) { const int r = EPI_R(s); f32x4 p0 = acc[ai][0][m][0], p1 = acc[ai][0][m][1], q0 = acc[ai][1][m][0], q1 = acc[ai][1][m][1];
#pragma unroll
                for (int e = 0; e < 4; ++e) { p0[e] = 1.0f + __builtin_amdgcn_exp2f(p0[e]); p1[e] = 1.0f + __builtin_amdgcn_exp2f(p1[e]);
                    q0[e] = p0[e] * __builtin_amdgcn_rcpf(1.0f + __builtin_amdgcn_exp2f(q0[e])); q1[e] = p1[e] * __builtin_amdgcn_rcpf(1.0f + __builtin_amdgcn_exp2f(q1[e])); }
                __builtin_nontemporal_store(pack8(p0, p1), (u32x4*)(A6 + (size_t)r * 1280 + 256 + cp)); __builtin_nontemporal_store(pack8(q0, q1), (u32x4*)(GS + (size_t)r * 1024 + cp)); }
            return;
        }
        bf16_t* base; int ld, c0, act;
        if (pn < 4) { base = Z; ld = 1024; c0 = pn * 256; act = 0; }
        else if (pn < 8) { base = YY + 512; ld = 1536; c0 = (pn - 4) * 256; act = 0; }
        else if (pn < 12) { base = YY; ld = 1536; c0 = (pn - 10) * 256; act = 0; }
        else if (pn < 16) { base = A6 + 256; ld = 1280; c0 = (pn - 12) * 256; act = 3; }
        else if (pn < 20) { base = GS; ld = 1024; c0 = (pn - 16) * 256; act = 2; }
        else { base = PG; ld = 1024; c0 = (pn - 20) * 256; act = 2; }
        EPI_ROWS(s) { const int r = EPI_R(s);
#pragma unroll
            for (int bj = 0; bj < 2; ++bj) { const int c = c0 + wc * 64 + bj * 32 + fq * 8;
                f32x4 v0 = acc[ai][bj][m][0], v1 = acc[ai][bj][m][1];
                if (act) {
#pragma unroll
                    for (int e = 0; e < 4; ++e) { v0[e] = 1.0f + __builtin_amdgcn_exp2f(v0[e]); v1[e] = 1.0f + __builtin_amdgcn_exp2f(v1[e]); }
                    if (act == 2) {
#pragma unroll
                        for (int e = 0; e < 4; ++e) { v0[e] = __builtin_amdgcn_rcpf(v0[e]); v1[e] = __builtin_amdgcn_rcpf(v1[e]); } } }
                __builtin_nontemporal_store(pack8(v0, v1), (u32x4*)(base + (size_t)r * ld + c)); } }
    }
};
struct EpiState {
    static constexpr bool AFTER_DRAIN = true;
    bf16_t* UA; const f32x2* AL;
    __device__ __forceinline__ void mid(Acc&, const Seg&, int, int, int, int) const {}
    __device__ __forceinline__ void fin(Acc&, const Seg&, int, int, int, int) const {}
    __device__ __forceinline__ void fused(Acc& acc, const Seg& s, int wr, int wc, int fr, int fq, LAS unsigned char* lds) const {
        LAS float* Sl = (LAS float*)lds;
        if (wc < 2) {
            EPI_ROWS(s) { const int rl = ai * 128 + wr * 64 + m * 16 + fr;
#pragma unroll
                for (int bj = 0; bj < 2; ++bj) { const int c = wc * 64 + bj * 32 + fq * 8; *(LAS f32x4*)(Sl + rl * 128 + c) = acc[ai][bj][m][0]; *(LAS f32x4*)(Sl + rl * 128 + c + 4) = acc[ai][bj][m][1]; } } }
        __syncthreads();
        const int tid = tid_local(), bl = tid >> 6, p = tid & 63;
        if (bl < 4) {
            const f32x2 al = AL[s.g * 64 + p];
            float er = 0.f, ei = 0.f;
            bf16_t* dst = UA + (size_t)s.g * (1024 * 640) + (size_t)(s.pm * 256 + bl * 64) * 640 + 512 + p;
            for (int c = 0; c < 64; ++c) {
                const float sr = Sl[(bl * 64 + c) * 128 + p], si = Sl[(bl * 64 + c) * 128 + 64 + p];
                const unsigned w = cvt_pk_bf16(er, ei);
                dst[(size_t)c * 640] = (bf16_t)(w & 0xffffu); dst[(size_t)c * 640 + 64] = (bf16_t)(w >> 16);
                const float nr = al.x * er - al.y * ei + sr, ni = al.x * ei + al.y * er + si; er = nr; ei = ni;
            }
        }
        __syncthreads();
    }
};
struct EpiS5Out {
    static constexpr bool AFTER_DRAIN = false;
    const bf16_t* __restrict__ UA; const float* __restrict__ dskip; bf16_t* __restrict__ GY;
    __device__ __forceinline__ void mid(Acc&, const Seg&, int, int, int, int) const {}
    __device__ __forceinline__ void fin(Acc& acc, const Seg& s, int wr, int wc, int fr, int fq) const {
        f32x4 d0[2], d1[2];
#pragma unroll
        for (int bj = 0; bj < 2; ++bj) { const int h0 = EPI_C(s, bj) & 15; d0[bj] = *(const f32x4*)(dskip + s.g * 16 + h0); d1[bj] = *(const f32x4*)(dskip + s.g * 16 + h0 + 4); }
#pragma unroll
        for (int ai = 0; ai < 2; ++ai) {
            u32x4 uw[4][2];
#pragma unroll
            for (int m = 0; m < 4; ++m)
#pragma unroll
                for (int bj = 0; bj < 2; ++bj) uw[m][bj] = *(const u32x4*)(UA + (size_t)s.g * (1024 * 640) + (size_t)EPI_R(s) * 640 + EPI_C(s, bj));
#pragma unroll
            for (int m = 0; m < 4; ++m) { const int R = EPI_R(s);
#pragma unroll
                for (int bj = 0; bj < 2; ++bj) { const int c = EPI_C(s, bj); const int t = c >> 4, h0 = c & 15; f32x4 u0, u1; unpack8(uw[m][bj], u0, u1);
                    const f32x4 v0 = gelu4(acc[ai][bj][m][0] + d0[bj] * u0), v1 = gelu4(acc[ai][bj][m][1] + d1[bj] * u1);
                    *(u32x4*)(GY + (size_t)(R * 32 + t) * 512 + s.g * 16 + h0) = pack8(v0, v1); } }
            asm volatile("" ::: "memory");
        }
    }
};
struct EpiGlu {
    static constexpr bool AFTER_DRAIN = false;
    const bf16_t* __restrict__ GY; const float* __restrict__ bias; bf16_t* YY;
    __device__ __forceinline__ void mid(Acc&, const Seg&, int, int, int, int) const {}
    __device__ __forceinline__ void fin(Acc& acc, const Seg& s, int wr, int wc, int fr, int fq) const {
        f32x4 b0[2], b1[2];
#pragma unroll
        for (int bj = 0; bj < 2; ++bj) { const int c = EPI_C(s, bj); b0[bj] = *(const f32x4*)(bias + c); b1[bj] = *(const f32x4*)(bias + c + 4); }
#pragma unroll
        for (int aim = 0; aim < 4; ++aim) { const int ai = aim >> 1, mh = aim & 1;
            u32x4 gw[2][2], sw[2][2];
#pragma unroll
            for (int mm = 0; mm < 2; ++mm)
#pragma unroll
                for (int bj = 0; bj < 2; ++bj) { const int m = mh * 2 + mm; const int r = EPI_R(s), c = EPI_C(s, bj); gw[mm][bj] = *(const u32x4*)(GY + (size_t)r * 512 + c); sw[mm][bj] = *(const u32x4*)(YY + (size_t)r * 1536 + c); }
#pragma unroll
            for (int mm = 0; mm < 2; ++mm)
#pragma unroll
                for (int bj = 0; bj < 2; ++bj) { const int m = mh * 2 + mm; const int r = EPI_R(s), c = EPI_C(s, bj); f32x4 g0, g1, s0, s1; unpack8(gw[mm][bj], g0, g1); unpack8(sw[mm][bj], s0, s1); s0 = s0 * sigm4(s0); s1 = s1 * sigm4(s1);
                    const f32x4 v0 = g0 * sigm4(acc[ai][bj][m][0] + b0[bj]) * s0, v1 = g1 * sigm4(acc[ai][bj][m][1] + b1[bj]) * s1;
                    *(u32x4*)(YY + (size_t)r * 1536 + c) = pack8(v0, v1); }
            asm volatile("" ::: "memory");
        }
    }
};
struct EpiMerge {
    static constexpr bool AFTER_DRAIN = false;
    const bf16_t* __restrict__ GS; bf16_t* A6;
    __device__ __forceinline__ void mid(Acc& acc, const Seg& s, int wr, int wc, int fr, int fq) const {
#pragma unroll
        for (int ai = 0; ai < 2; ++ai) {
            u32x4 aw[4][2];
#pragma unroll
            for (int m = 0; m < 4; ++m)
#pragma unroll
                for (int bj = 0; bj < 2; ++bj) aw[m][bj] = *(const u32x4*)(GS + (size_t)EPI_R(s) * 1024 + EPI_C(s, bj));
#pragma unroll
            for (int m = 0; m < 4; ++m)
#pragma unroll
                for (int bj = 0; bj < 2; ++bj) { f32x4 a0, a1; unpack8(aw[m][bj], a0, a1); acc[ai][bj][m][0] *= a0; acc[ai][bj][m][1] *= a1; }
            asm volatile("" ::: "memory");
        }
    }
    __device__ __forceinline__ void fin(Acc& acc, const Seg& s, int wr, int wc, int fr, int fq) const {
#pragma unroll
        for (int ai = 0; ai < 2; ++ai) {
            u32x4 bw[4][2];
#pragma unroll
            for (int m = 0; m < 4; ++m)
#pragma unroll
                for (int bj = 0; bj < 2; ++bj) bw[m][bj] = *(const u32x4*)(A6 + (size_t)EPI_R(s) * 1280 + 256 + EPI_C(s, bj));
#pragma unroll
            for (int m = 0; m < 4; ++m)
#pragma unroll
                for (int bj = 0; bj < 2; ++bj) { f32x4 b0, b1; unpack8(bw[m][bj], b0, b1);
#pragma unroll
                    for (int e = 0; e < 4; ++e) { b0[e] = __builtin_amdgcn_rcpf(b0[e]); b1[e] = __builtin_amdgcn_rcpf(b1[e]); }
                    *(u32x4*)(A6 + (size_t)EPI_R(s) * 1280 + 256 + EPI_C(s, bj)) = pack8(acc[ai][bj][m][0] * b0, acc[ai][bj][m][1] * b1); }
            asm volatile("" ::: "memory");
        }
    }
};
struct EpiOut {
    static constexpr bool AFTER_DRAIN = false;
    const bf16_t* __restrict__ PG; const float* __restrict__ x; float* __restrict__ out; f32x2* __restrict__ stats;
    __device__ __forceinline__ void mid(Acc& acc, const Seg& s, int wr, int wc, int fr, int fq) const {
#pragma unroll
        for (int ai = 0; ai < 2; ++ai) {
            u32x4 aw[4][2];
#pragma unroll
            for (int m = 0; m < 4; ++m)
#pragma unroll
                for (int bj = 0; bj < 2; ++bj) aw[m][bj] = *(const u32x4*)(PG + (size_t)EPI_R(s) * 1024 + EPI_C(s, bj));
#pragma unroll
            for (int m = 0; m < 4; ++m)
#pragma unroll
                for (int bj = 0; bj < 2; ++bj) { f32x4 a0, a1; unpack8(aw[m][bj], a0, a1); acc[ai][bj][m][0] *= a0; acc[ai][bj][m][1] *= a1; }
            asm volatile("" ::: "memory");
        }
    }
    __device__ __forceinline__ void fin(Acc& acc, const Seg& s, int wr, int wc, int fr, int fq) const {
#pragma unroll
        for (int aim = 0; aim < 4; ++aim) { const int ai = aim >> 1, mh = aim & 1;
            f32x4 xv[2][2][2];
#pragma unroll
            for (int mm = 0; mm < 2; ++mm)
#pragma unroll
                for (int bj = 0; bj < 2; ++bj) { const int m = mh * 2 + mm; const float* xp = x + (size_t)EPI_R(s) * 1024 + EPI_C(s, bj); xv[mm][bj][0] = __builtin_nontemporal_load((const f32x4*)xp); xv[mm][bj][1] = __builtin_nontemporal_load((const f32x4*)(xp + 4)); }
#pragma unroll
            for (int mm = 0; mm < 2; ++mm) { const int m = mh * 2 + mm; const int r = EPI_R(s); float s1 = 0.f, s2 = 0.f;
#pragma unroll
                for (int bj = 0; bj < 2; ++bj) { float* op = out + (size_t)r * 1024 + EPI_C(s, bj);
                    const f32x4 h0 = xv[mm][bj][0] * ALPHA + acc[ai][bj][m][0], h1 = xv[mm][bj][1] * ALPHA + acc[ai][bj][m][1];
                    *(f32x4*)op = h0; *(f32x4*)(op + 4) = h1;
                    s1 += (h0[0] + h0[1]) + (h0[2] + h0[3]) + (h1[0] + h1[1]) + (h1[2] + h1[3]);
                    s2 += (h0[0] * h0[0] + h0[1] * h0[1]) + (h0[2] * h0[2] + h0[3] * h0[3]) + (h1[0] * h1[0] + h1[1] * h1[1]) + (h1[2] * h1[2] + h1[3] * h1[3]); }
                s1 += __shfl_xor(s1, 16); s1 += __shfl_xor(s1, 32); s2 += __shfl_xor(s2, 16); s2 += __shfl_xor(s2, 32);
                if (fq == 0) stats[(size_t)r * 16 + s.pn * 4 + wc] = (f32x2){s1, s2}; }
            asm volatile("" ::: "memory");
        }
    }
};
struct EpiOutLn {
    static constexpr bool AFTER_DRAIN = true;
    const bf16_t* __restrict__ PG; const float* __restrict__ x; float* __restrict__ out; const float* __restrict__ lg; const float* __restrict__ lb;
    unsigned long long* xbuf; unsigned* cnt; unsigned* tmo;
    __device__ __forceinline__ void mid(Acc& acc, const Seg& s, int wr, int wc, int fr, int fq) const {
#pragma unroll
        for (int ai = 0; ai < 2; ++ai) {
            u32x4 aw[4][2];
#pragma unroll
            for (int m = 0; m < 4; ++m)
#pragma unroll
                for (int bj = 0; bj < 2; ++bj) aw[m][bj] = *(const u32x4*)(PG + (size_t)EPI_R(s) * 1024 + EPI_C(s, bj));
#pragma unroll
            for (int m = 0; m < 4; ++m)
#pragma unroll
                for (int bj = 0; bj < 2; ++bj) { f32x4 a0, a1; unpack8(aw[m][bj], a0, a1); acc[ai][bj][m][0] *= a0; acc[ai][bj][m][1] *= a1; }
            asm volatile("" ::: "memory");
        }
    }
    __device__ __forceinline__ void fin(Acc&, const Seg&, int, int, int, int) const {}
    __device__ __forceinline__ void fused(Acc& acc, const Seg& s, int wr, int wc, int fr, int fq, LAS unsigned char* lds) const {
        LAS f32x2* Pt = (LAS f32x2*)lds;
        LAS f32x2* St = (LAS f32x2*)(lds + 8192);
        const int tl = tid_local(), wid = tl >> 6, lane = tl & 63;
#pragma unroll
        for (int aim = 0; aim < 4; ++aim) { const int ai = aim >> 1, mh = aim & 1;
            f32x4 xv[2][2][2];
#pragma unroll
            for (int mm = 0; mm < 2; ++mm)
#pragma unroll
                for (int bj = 0; bj < 2; ++bj) { const int m = mh * 2 + mm; const float* xp = x + (size_t)EPI_R(s) * 1024 + EPI_C(s, bj); xv[mm][bj][0] = __builtin_nontemporal_load((const f32x4*)xp); xv[mm][bj][1] = __builtin_nontemporal_load((const f32x4*)(xp + 4)); }
#pragma unroll
            for (int mm = 0; mm < 2; ++mm) { const int m = mh * 2 + mm; float s1 = 0.f, s2 = 0.f;
#pragma unroll
                for (int bj = 0; bj < 2; ++bj) { const f32x4 h0 = xv[mm][bj][0] * ALPHA + acc[ai][bj][m][0], h1 = xv[mm][bj][1] * ALPHA + acc[ai][bj][m][1];
                    acc[ai][bj][m][0] = h0; acc[ai][bj][m][1] = h1;
                    s1 += (h0[0] + h0[1]) + (h0[2] + h0[3]) + (h1[0] + h1[1]) + (h1[2] + h1[3]);
                    s2 += (h0[0] * h0[0] + h0[1] * h0[1]) + (h0[2] * h0[2] + h0[3] * h0[3]) + (h1[0] * h1[0] + h1[1] * h1[1]) + (h1[2] * h1[2] + h1[3] * h1[3]); }
                s1 += __shfl_xor(s1, 16); s1 += __shfl_xor(s1, 32); s2 += __shfl_xor(s2, 16); s2 += __shfl_xor(s2, 32);
                if (fq == 0) Pt[(ai * 128 + wr * 64 + m * 16 + fr) * 4 + wc] = (f32x2){s1, s2}; }
            asm volatile("" ::: "memory"); __builtin_amdgcn_sched_barrier(0);
        }
        __syncthreads();
        const int row = wid * 32 + (lane & 31);
        if (lane < 32) { const f32x2 a = Pt[row * 4 + 0], b = Pt[row * 4 + 1], c = Pt[row * 4 + 2], d = Pt[row * 4 + 3];
            const float t1 = (a.x + b.x) + (c.x + d.x), t2 = (a.y + b.y) + (c.y + d.y);
            __hip_atomic_store(xbuf + ((size_t)(s.pm * 256 + row) * 4 + s.pn), ((unsigned long long)__float_as_uint(t2) << 32) | __float_as_uint(t1), __ATOMIC_RELAXED, __HIP_MEMORY_SCOPE_AGENT); }
        asm volatile("s_waitcnt vmcnt(0)" ::: "memory");
        if (lane == 0) __hip_atomic_fetch_add(cnt + 64 * s.pm, 1u, __ATOMIC_RELAXED, __HIP_MEMORY_SCOPE_AGENT);
        if (wid == 0) { unsigned sp = 0;
            while ((unsigned)__builtin_amdgcn_readfirstlane(__hip_atomic_load(cnt + 64 * s.pm, __ATOMIC_RELAXED, __HIP_MEMORY_SCOPE_AGENT)) < 32u) {
                __builtin_amdgcn_s_sleep(1);
                if ((++sp & 255u) == 0u) { if (xb_ld(tmo)) break; if (sp > XB_SPIN_CAP) { if (lane == 0) atomicAdd(tmo, 1u); break; } } }
            __builtin_amdgcn_fence(__ATOMIC_ACQUIRE, "agent"); }
        asm volatile("s_waitcnt vmcnt(0) lgkmcnt(0)" ::: "memory");
        __syncthreads();
        if (lane < 32) { float t1 = 0.f, t2 = 0.f;
#pragma unroll
            for (int t = 0; t < 4; ++t) { const unsigned long long w = __hip_atomic_load(xbuf + ((size_t)(s.pm * 256 + row) * 4 + t), __ATOMIC_RELAXED, __HIP_MEMORY_SCOPE_AGENT); t1 += __uint_as_float((unsigned)w); t2 += __uint_as_float((unsigned)(w >> 32)); }
            const float mean = t1 * (1.0f / 1024.0f), var = fmaxf(t2 * (1.0f / 1024.0f) - mean * mean, 0.f);
            St[row] = (f32x2){mean, 1.0f / sqrtf(var + LN_EPS)}; }
        __syncthreads();
        f32x4 g0[2], g1[2], b0[2], b1[2];
#pragma unroll
        for (int bj = 0; bj < 2; ++bj) { const int c = EPI_C(s, bj); g0[bj] = *(const f32x4*)(lg + c); g1[bj] = *(const f32x4*)(lg + c + 4); b0[bj] = *(const f32x4*)(lb + c); b1[bj] = *(const f32x4*)(lb + c + 4); }
#pragma unroll
        for (int ai = 0; ai < 2; ++ai)
#pragma unroll
            for (int m = 0; m < 4; ++m) { const int rl = ai * 128 + wr * 64 + m * 16 + fr; const f32x2 sr = St[rl]; const float nb = -sr.x * sr.y;
#pragma unroll
                for (int bj = 0; bj < 2; ++bj) { float* op = out + (size_t)EPI_R(s) * 1024 + EPI_C(s, bj);
                    const f32x4 o0 = (acc[ai][bj][m][0] * sr.y + nb) * g0[bj] + b0[bj], o1 = (acc[ai][bj][m][1] * sr.y + nb) * g1[bj] + b1[bj];
                    *(f32x4*)op = o0; *(f32x4*)(op + 4) = o1; } }
        __syncthreads();
    }
};
}

__device__ __forceinline__ void tconv_tile(LAS float* t, const float* in, int ld_in, bf16_t* out, int ld_out, int k0, int n0) {
    const int tid = tid_local();
    { const int kr = tid >> 4, c4 = tid & 15;
#pragma unroll
      for (int ps = 0; ps < 2; ++ps) { const int k = kr + ps * 32; const f32x4 v = *(const f32x4*)(in + (size_t)(k0 + k) * ld_in + n0 + c4 * 4);
          t[k * 65 + c4 * 4 + 0] = v[0]; t[k * 65 + c4 * 4 + 1] = v[1]; t[k * 65 + c4 * 4 + 2] = v[2]; t[k * 65 + c4 * 4 + 3] = v[3]; } }
    __syncthreads();
    { const int nr = tid >> 3, k8 = tid & 7; f32x4 a, b;
#pragma unroll
      for (int e = 0; e < 4; ++e) { a[e] = t[(k8 * 8 + e) * 65 + nr]; b[e] = t[(k8 * 8 + 4 + e) * 65 + nr]; }
      *(u32x4*)(out + (size_t)(n0 + nr) * ld_out + k0 + k8 * 8) = pack8(a, b); }
    __syncthreads();
}

__device__ __forceinline__ void prep_a(LAS unsigned char* lds, const Params& P, int bid, int G) {
    unsigned char* ws = P.ws; const int tid = tid_local();
    bf16_t* WT1 = (bf16_t*)(ws + OFF_WT1); bf16_t* WINP = (bf16_t*)(ws + OFF_WINP); bf16_t* PWT = (bf16_t*)(ws + OFF_PWT); bf16_t* GLT = (bf16_t*)(ws + OFF_GLT);
    bf16_t* W5 = (bf16_t*)(ws + OFF_W5); bf16_t* W6 = (bf16_t*)(ws + OFF_W6); bf16_t* WT2 = (bf16_t*)(ws + OFF_WT2); bf16_t* BT3 = (bf16_t*)(ws + OFF_BT3);
    float* KTAB = (float*)(ws + OFF_KTAB); f32x2* AL = (f32x2*)(ws + OFF_AL);
    for (int task = bid; task < 256; task += G) {
        const int g = task >> 3, q = task & 7;
        LAS f32x2* PW = (LAS f32x2*)lds;
        LAS f32x2* Bb = PW + 33 * 64;
        LAS f32x2* Cc = Bb + 64 * 16;
        const float* a_re = P.in[5] + g * 64; const float* a_im = P.in[6] + g * 64; const float dt = expf(P.in[7][g]);
        for (int e = tid; e < 33 * 64; e += NTHR) { const int j = e >> 6, p = e & 63; const float lr = a_re[p], li = a_im[p];
            const float mag = expf(lr * dt * (float)j);
            double rev = (double)li * (double)dt * (double)j * 0.15915494309189535; rev -= floor(rev); const float rv = (float)rev;
            PW[e] = (f32x2){mag * __builtin_amdgcn_cosf(rv), mag * __builtin_amdgcn_sinf(rv)}; }
        __syncthreads();
        for (int e = tid; e < 1024; e += NTHR) { const int p = e >> 4, h = e & 15; const float lr = a_re[p], li = a_im[p]; const f32x2 ab = PW[64 + p];
            const float xr = ab.x - 1.0f, xi = ab.y, den = lr * lr + li * li;
            const float zr = (xr * lr + xi * li) / den, zi = (xi * lr - xr * li) / den;
            const float br = P.in[8][(size_t)(g * 64 + p) * 16 + h], bi = P.in[9][(size_t)(g * 64 + p) * 16 + h];
            Bb[e] = (f32x2){zr * br - zi * bi, zr * bi + zi * br};
            Cc[e] = (f32x2){P.in[10][(size_t)g * 1024 + e], P.in[11][(size_t)g * 1024 + e]}; }
        __syncthreads();
        for (int e = tid; e < 1024; e += NTHR) { const int j = 4 * q + (e >> 8), h = (e >> 4) & 15, h2 = e & 15; float a = 0.f;
            for (int p = 0; p < 64; ++p) { const f32x2 w = PW[j * 64 + p], bb = Bb[p * 16 + h2], cc = Cc[h * 64 + p];
                const float wr_ = w.x * bb.x - w.y * bb.y, wi_ = w.x * bb.y + w.y * bb.x; a += cc.x * wr_ - cc.y * wi_; }
            KTAB[((size_t)(g * 32 + j) * 16 + h) * 16 + h2] = a; }
        for (int v = tid; v < 2048; v += NTHR) { const int n = v >> 3, k0 = 64 * q + (v & 7) * 8, sx = k0 >> 4, h0 = k0 & 15; f32x4 a = {0.f, 0.f, 0.f, 0.f}, b = {0.f, 0.f, 0.f, 0.f};
            if (n < 128) { const int p = n & 63; const bool im = n >= 64; const f32x2 w = PW[(31 - sx) * 64 + p];
#pragma unroll
                for (int e = 0; e < 8; ++e) { const f32x2 bb = Bb[p * 16 + h0 + e]; const float val = im ? (w.x * bb.y + w.y * bb.x) : (w.x * bb.x - w.y * bb.y); if (e < 4) a[e] = val; else b[e - 4] = val; } }
            *(u32x4*)(WT2 + (size_t)(g * 256 + n) * 512 + k0) = pack8(a, b); }
        for (int v = tid; v < 1024; v += NTHR) { const int n = 64 * q + (v >> 4), t = n >> 4, h = n & 15, k0 = (v & 15) * 8; const bool im = k0 >= 64; const int p0 = k0 & 63; f32x4 a, b;
#pragma unroll
            for (int e = 0; e < 8; ++e) { const int p = p0 + e; const f32x2 w = PW[(t + 1) * 64 + p], cc = Cc[h * 64 + p];
                const float val = im ? -(cc.x * w.y + cc.y * w.x) : (cc.x * w.x - cc.y * w.y); if (e < 4) a[e] = val; else b[e - 4] = val; }
            *(u32x4*)(BT3 + (size_t)(g * 512 + n) * 640 + 512 + k0) = pack8(a, b); }
        if (q == 0 && tid < 64) AL[g * 64 + tid] = PW[32 * 64 + tid];
        __syncthreads();
    }
    LAS float* tt = (LAS float*)lds;
#define TC_JOB(x) \
        const float* in; int ld_in, ld_out, nT, xx; bf16_t* out; float wsc = 1.0f; int pcol = -1; \
        if ((x) < 1280)      { xx = (x);        in = P.in[2] + 1024; ld_in = 6144; out = WT1 + (size_t)1024 * 1024; ld_out = 1024; nT = 80; } \
        else if ((x) < 1344) { xx = (x) - 1280; in = P.in[13];       ld_in = 512;  out = GLT;       ld_out = 512;  nT = 8; } \
        else if ((x) < 1472) { xx = (x) - 1344; in = P.in[16];       ld_in = 1024; out = W5;        ld_out = 1536; nT = 16; } \
        else if ((x) < 1728) { xx = (x) - 1472; in = P.in[15];       ld_in = 1024; out = W5 + 512;  ld_out = 1536; nT = 16; } \
        else if ((x) < 1792) { xx = (x) - 1728; in = P.in[18];       ld_in = 1024; out = W6;        ld_out = 1280; nT = 16; } \
        else if ((x) < 2048) { xx = (x) - 1792; in = P.in[17];       ld_in = 1024; out = W6 + 256;  ld_out = 1280; nT = 16; } \
        else                 { xx = (x) - 2048; in = P.in[3];        ld_in = 256;  out = PWT;       ld_out = 1024; nT = 4; } \
        const int k0 = (xx / nT) * 64, n0 = (xx % nT) * 64; if ((x) < 1280 && n0 >= 2048) wsc = -1.4426950408889634f;     \
        if ((x) < 1280 && n0 >= 2048 && n0 < 4096) { const int j = (n0 - 2048) >> 6; pcol = 3072 + (j >> 2) * 128 + (j & 3) * 32; }     \
        (void)in; (void)ld_in; (void)out; (void)ld_out; (void)wsc; (void)pcol;
    for (int xb = bid; xb < 2112; xb += 5 * G) {
        f32x4 v[5][2];
        const int kr = tid >> 4, c4 = tid & 15;
#pragma unroll
        for (int j = 0; j < 5; ++j) { const int x = xb + j * G; if (x < 2112) { TC_JOB(x)
#pragma unroll
            for (int ps = 0; ps < 2; ++ps) { const float* src = (pcol < 0) ? in + (size_t)(k0 + kr + ps * 32) * ld_in + n0 + c4 * 4 : P.in[2] + (size_t)(k0 + kr + ps * 32) * 6144 + (c4 < 8 ? pcol + c4 * 4 : pcol + 1024 + (c4 - 8) * 4);
                v[j][ps] = *(const f32x4*)src; } } }
#pragma unroll
        for (int j = 0; j < 5; ++j) { const int x = xb + j * G; if (x < 2112) { LAS float* t = tt + j * (64 * 65);
#pragma unroll
            for (int ps = 0; ps < 2; ++ps) { const int k = kr + ps * 32; t[k * 65 + c4 * 4 + 0] = v[j][ps][0]; t[k * 65 + c4 * 4 + 1] = v[j][ps][1]; t[k * 65 + c4 * 4 + 2] = v[j][ps][2]; t[k * 65 + c4 * 4 + 3] = v[j][ps][3]; } } }
        __syncthreads();
        const int nr = tid >> 3, k8 = tid & 7;
#pragma unroll
        for (int j = 0; j < 5; ++j) { const int x = xb + j * G; if (x < 2112) { TC_JOB(x) const LAS float* t = tt + j * (64 * 65); f32x4 a, b;
#pragma unroll
            for (int e = 0; e < 4; ++e) { a[e] = t[(k8 * 8 + e) * 65 + nr] * wsc; b[e] = t[(k8 * 8 + 4 + e) * 65 + nr] * wsc; }
            *(u32x4*)(out + (size_t)(n0 + nr) * ld_out + k0 + k8 * 8) = pack8(a, b); } }
        __syncthreads();
    }
#undef TC_JOB
    for (int v = bid * NTHR + tid; v < 1024 * 128; v += G * NTHR) { const int d = v >> 7, i0 = (v & 127) * 8; const float* src = P.in[2] + (size_t)d * 6144 + i0;
        *(u32x4*)(WINP + (size_t)d * 1024 + i0) = pack8(*(const f32x4*)src, *(const f32x4*)(src + 4)); }
}

__device__ __forceinline__ void fold_prelude(LAS unsigned char* lds, const Params& P, int f) {
    unsigned char* ws = P.ws; const int tid = tid_local(); const int g = f >> 2, pn = f & 3;
    bf16_t* WINP = (bf16_t*)(ws + OFF_WINP); bf16_t* PWT = (bf16_t*)(ws + OFF_PWT);
    LAS float* tt = (LAS float*)lds;
    for (int x = 0; x < 16; ++x) tconv_tile(tt, P.in[3], 256, PWT, 1024, (4 * g + (x >> 2)) * 64, (x & 3) * 64);
    for (int v = tid; v < 8192; v += NTHR) { const int d = 256 * pn + (v >> 5), i0 = 256 * g + (v & 31) * 8; const float* src = P.in[2] + (size_t)d * 6144 + i0;
        *(u32x4*)(WINP + (size_t)d * 1024 + i0) = pack8(*(const f32x4*)src, *(const f32x4*)(src + 4)); }
    asm volatile("s_waitcnt vmcnt(0)" ::: "memory");
    __syncthreads();
}

__device__ __forceinline__ void prep_b_stream(const Params& P, int bi, int nb) {
    unsigned char* ws = P.ws; const size_t gt = (size_t)bi * NTHR + tid_local(), gn = (size_t)nb * NTHR;
    bf16_t* BT3 = (bf16_t*)(ws + OFF_BT3); const float* KTAB = (const float*)(ws + OFF_KTAB); bf16_t* XB = (bf16_t*)(ws + OFF_XB); bf16_t* A6 = (bf16_t*)(ws + OFF_A6);
    { const float* x = P.in[0]; const size_t N = (size_t)T * 128;
      for (size_t v = gt; v < N; v += 8 * gn) { f32x4 a[8], b[8];
#pragma unroll
          for (int u = 0; u < 8; ++u) { const size_t i = v + u * gn; if (i < N) { a[u] = __builtin_nontemporal_load((const f32x4*)(x + i * 8)); b[u] = __builtin_nontemporal_load((const f32x4*)(x + i * 8 + 4)); } }
#pragma unroll
          for (int u = 0; u < 8; ++u) { const size_t i = v + u * gn; if (i < N) *(u32x4*)(XB + i * 8) = pack8(a[u], b[u]); } } }
}

__device__ __forceinline__ void p_convert(const Params& P, int bi, int nb) {
    const size_t gt = (size_t)bi * NTHR + tid_local(), gn = (size_t)nb * NTHR; bf16_t* A6 = (bf16_t*)(P.ws + OFF_A6);
    { const float* p = P.in[1]; const size_t N = (size_t)T * 32;
      for (size_t v = gt; v < N; v += 8 * gn) { f32x4 a[8], b[8];
#pragma unroll
          for (int u = 0; u < 8; ++u) { const size_t i = v + u * gn; if (i < N) { a[u] = __builtin_nontemporal_load((const f32x4*)(p + i * 8)); b[u] = __builtin_nontemporal_load((const f32x4*)(p + i * 8 + 4)); } }
#pragma unroll
          for (int u = 0; u < 8; ++u) { const size_t i = v + u * gn; if (i < N) { const size_t r = i >> 5; const int c = (int)(i & 31) * 8; *(u32x4*)(A6 + r * 1280 + c) = pack8(a[u], b[u]); } } } }
}

__device__ __forceinline__ void bt3_expand(const Params& P, int bi, int nb) {
    unsigned char* ws = P.ws; const size_t gt = (size_t)bi * NTHR + tid_local(), gn = (size_t)nb * NTHR;
    bf16_t* BT3 = (bf16_t*)(ws + OFF_BT3); const float* KTAB = (const float*)(ws + OFF_KTAB);
    { const size_t N = (size_t)32 * 512 * 64;
      for (size_t v0 = gt; v0 < N; v0 += 8 * gn) { f32x4 a[8], b[8];
#pragma unroll
          for (int u = 0; u < 8; ++u) { const size_t v = v0 + u * gn; a[u] = (f32x4){0.f, 0.f, 0.f, 0.f}; b[u] = a[u];
              if (v < N) { const int kv = (int)(v & 63), n = (int)((v >> 6) & 511), g = (int)(v >> 15); const int t = n >> 4, h = n & 15, k0 = kv * 8, sx = k0 >> 4, h0 = k0 & 15;
                  if (sx <= t) { const float* src = KTAB + ((size_t)(g * 32 + (t - sx)) * 16 + h) * 16 + h0; a[u] = *(const f32x4*)src; b[u] = *(const f32x4*)(src + 4); } } }
#pragma unroll
          for (int u = 0; u < 8; ++u) { const size_t v = v0 + u * gn;
              if (v < N) { const int kv = (int)(v & 63), n = (int)((v >> 6) & 511), g = (int)(v >> 15); *(u32x4*)(BT3 + (size_t)(g * 512 + n) * 640 + kv * 8) = pack8(a[u], b[u]); } } } }
}

template <int W>
__device__ __forceinline__ void pool_run(const bf16_t* Z, bf16_t* YY, const float* scale, int t0, int c) {
    constexpr int NR = W + 7;
    const int pos0 = t0 & 2047;
    u32x4 rows[NR], gts[8];
#pragma unroll
    for (int j = 0; j < NR; ++j) { const int d = j - (W - 1); const bool ok = (pos0 + d) >= 0; const int tk = ok ? t0 + d : t0;
        u32x4 w = *(const u32x4*)(Z + (size_t)tk * 1024 + c); if (!ok) w = (u32x4){0u, 0u, 0u, 0u}; rows[j] = w; }
    bf16_t* yp = YY + (size_t)t0 * 1536 + 512 + c;
#pragma unroll
    for (int i = 0; i < 8; ++i) gts[i] = *(const u32x4*)(yp + (size_t)i * 1536);
    const f32x4 sc0 = *(const f32x4*)(scale + c), sc1 = *(const f32x4*)(scale + c + 4);
    f32x4 s0 = {0.f, 0.f, 0.f, 0.f}, s1 = {0.f, 0.f, 0.f, 0.f};
#pragma unroll
    for (int j = 0; j < W; ++j) { f32x4 a, b; unpack8(rows[j], a, b); s0 += a; s1 += b; }
#pragma unroll
    for (int i = 0; i < 8; ++i) {
        const int n = (pos0 + i + 1 < W) ? pos0 + i + 1 : W; const float inv = 1.0f / (float)n;
        f32x4 z0, z1, g0, g1; unpack8(rows[i + W - 1], z0, z1); unpack8(gts[i], g0, g1); g0 = g0 * sigm4(g0); g1 = g1 * sigm4(g1);
        *(u32x4*)(yp + (size_t)i * 1536) = pack8((s0 * inv - z0) * sc0 * g0, (s1 * inv - z1) * sc1 * g1);
        if (i < 7) { f32x4 a, b; unpack8(rows[i], a, b); s0 -= a; s1 -= b; unpack8(rows[i + W], a, b); s0 += a; s1 += b; }
    }
}
__device__ __forceinline__ void pool_pass(const Params& P, int wv, int nwv, int item0, int nitems) {
    const bf16_t* Z = (const bf16_t*)P.out; bf16_t* YY = (bf16_t*)(P.ws + OFF_YY); const float* scale = P.in[4];
    const int lane = tid_local() & 63;
    for (int it = wv; it < nitems; it += nwv) { const int item = item0 + it;
        const int gi = item / (T / 16), tr = item % (T / 16); const int t0 = (tr * 2 + (lane >> 5)) * 8, c = gi * 256 + (lane & 31) * 8;
        if (gi == 0) pool_run<2>(Z, YY, scale, t0, c); else if (gi == 1) pool_run<4>(Z, YY, scale, t0, c); else if (gi == 2) pool_run<8>(Z, YY, scale, t0, c); else pool_run<16>(Z, YY, scale, t0, c);
    }
}

__device__ __forceinline__ void ln_pass(const Params& P) {
    const f32x2* stats = (const f32x2*)(P.ws + OFF_STATS); float* out = P.out; const float* lg = P.in[19]; const float* lb = P.in[20];
    const int tl = tid_local(); const int lane = tl & 63, wv = blockIdx.x * (NTHR / 64) + (tl >> 6), nwv = gridDim.x * (NTHR / 64);
    f32x4 gg[4], bb[4];
#pragma unroll
    for (int i = 0; i < 4; ++i) { gg[i] = *(const f32x4*)(lg + i * 256 + lane * 4); bb[i] = *(const f32x4*)(lb + i * 256 + lane * 4); }
    for (int r0 = wv * 4; r0 < T; r0 += nwv * 4) {
        f32x4 h[4][4];
#pragma unroll
        for (int q = 0; q < 4; ++q)
#pragma unroll
            for (int i = 0; i < 4; ++i) h[q][i] = *(const f32x4*)(out + (size_t)(r0 + q) * 1024 + i * 256 + lane * 4);
        const f32x2 st = stats[(size_t)(r0 + (lane >> 4)) * 16 + (lane & 15)];
        float s1 = st.x, s2 = st.y;
#pragma unroll
        for (int o = 1; o < 16; o <<= 1) { s1 += __shfl_xor(s1, o); s2 += __shfl_xor(s2, o); }
#pragma unroll
        for (int q = 0; q < 4; ++q) {
            const float a1 = __shfl(s1, q * 16), a2 = __shfl(s2, q * 16);
            const float mu = a1 * (1.0f / 1024.0f); const float var = fmaxf(a2 * (1.0f / 1024.0f) - mu * mu, 0.f); const float rstd = 1.0f / sqrtf(var + LN_EPS);
#pragma unroll
            for (int i = 0; i < 4; ++i) { const f32x4 o = (h[q][i] - mu) * rstd * gg[i] + bb[i]; __builtin_nontemporal_store(o, (f32x4*)(out + (size_t)(r0 + q) * 1024 + i * 256 + lane * 4)); }
        }
    }
}

__global__ void __launch_bounds__(NTHR, 2) mega(Params P) {
    extern __shared__ __attribute__((aligned(16))) unsigned char lds_raw[];
    LAS unsigned char* lds = (LAS unsigned char*)lds_raw;
    unsigned char* ws = P.ws; const int G = gridDim.x, bid = blockIdx.x;
    bf16_t* XB = (bf16_t*)(ws + OFF_XB); bf16_t* GY = XB; bf16_t* YY = (bf16_t*)(ws + OFF_YY); bf16_t* A6 = (bf16_t*)(ws + OFF_A6); bf16_t* PG = (bf16_t*)(ws + OFF_PG);
    bf16_t* UA = (bf16_t*)(ws + OFF_UA); bf16_t* WT1 = (bf16_t*)(ws + OFF_WT1); bf16_t* WINP = (bf16_t*)(ws + OFF_WINP); bf16_t* PWT = (bf16_t*)(ws + OFF_PWT);
    bf16_t* GLT = (bf16_t*)(ws + OFF_GLT); bf16_t* W5 = (bf16_t*)(ws + OFF_W5); bf16_t* W6 = (bf16_t*)(ws + OFF_W6); bf16_t* WT2 = (bf16_t*)(ws + OFF_WT2); bf16_t* BT3 = (bf16_t*)(ws + OFF_BT3);
    bf16_t* Z = (bf16_t*)P.out; bf16_t* GS = Z + (size_t)T * 1024;
    if (threadIdx.x < 16) ((LAS unsigned*)(lds + LDS_STAGE))[threadIdx.x] = 0u;
    __syncthreads();
    const XcdBarrier gbar = xcd_barrier_post((unsigned*)(ws + OFF_CTL), (volatile LAS unsigned*)(lds + LDS_STAGE));
    if (ws == nullptr) cg::this_grid().sync();
#define GRID_BAR() xcd_barrier(gbar)
    const int xc = (G % 8 == 0) ? (bid % 8) * (G / 8) + bid / 8 : bid;

    if (G == 256) {
        if (bid < 88) prep_a(lds, P, bid, 88);
        else if (bid < 104) { fold_prelude(lds, P, bid - 88);
            pg8::Sched S{(const char*)PWT, (const char*)WINP, 512, 512, 1024, 1024, 1, 4, 4, 1, 0, 0, 4, 0, 0, 0, 16, bid - 88, 1};
            pg8::EpiFold E{WT1}; pg8::gemm_phase(lds, S, E); }
        else prep_b_stream(P, bid - 104, 152);
    } else {
        prep_a(lds, P, bid, G);
        GRID_BAR();
        { pg8::Sched S{(const char*)PWT, (const char*)WINP, 512, 512, 1024, 1024, 1, 4, 4, 1, 0, 0, 4, 0, 0, 0, G, bid, 1};
          pg8::EpiFold E{WT1}; pg8::gemm_phase(lds, S, E); }
        prep_b_stream(P, bid, G);
    }
    GRID_BAR();
    if (bid & 1) bt3_expand(P, bid >> 1, G >> 1);
    { pg8::Sched S{(const char*)XB, (const char*)WT1, 0, 0, 1024, 1024, 128, 24, 1, 1, 0, 0, 16, 0, 0, 0, G, bid, 0};
      pg8::EpiProj E{Z, YY, UA, A6, GS, PG}; pg8::gemm_phase(lds, S, E); }
    GRID_BAR();
    { pg8::Sched S{(const char*)UA, (const char*)WT2, (size_t)1024 * 640 * 2, (size_t)256 * 512 * 2, 640, 512, 4, 1, 32, 1, 0, 0, 8, 0, 0, 0, G, bid, 1};
      pg8::EpiState E{UA, (const f32x2*)(ws + OFF_AL)}; pg8::gemm_phase(lds, S, E);
      const int wv_in_blk = tid_local() >> 6; const int NIT = 4 * (T / 16);
      if (G == 256) { if (bid >= 128) pool_pass(P, (bid - 128) * 8 + wv_in_blk, 1024, 0, (NIT * 3) / 4); else pool_pass(P, bid * 8 + wv_in_blk, 1024, (NIT * 3) / 4, NIT / 4); }
      else pool_pass(P, bid * 8 + wv_in_blk, G * 8, 0, NIT); }
    GRID_BAR();
    { pg8::Sched S{(const char*)UA, (const char*)BT3, (size_t)1024 * 640 * 2, (size_t)512 * 640 * 2, 640, 640, 4, 2, 32, 1, 0, 0, 10, 0, 0, 0, G, xc, 1};
      pg8::EpiS5Out E{UA, P.in[12], GY}; pg8::gemm_phase(lds, S, E); }
    GRID_BAR();
    { pg8::Sched S{(const char*)GY, (const char*)GLT, 0, 0, 512, 512, 128, 2, 1, 1, 0, 0, 8, 0, 0, 0, G, bid, 0};
      pg8::EpiGlu E{GY, P.in[14], YY}; pg8::gemm_phase(lds, S, E); }
    GRID_BAR();
    if (bid & 1) p_convert(P, bid >> 1, G >> 1);
    { pg8::Sched S{(const char*)YY, (const char*)W5, 0, 0, 1536, 1536, 128, 4, 1, 2, 0, 0, 8, 512, 512, 16, G, bid, 0};
      pg8::EpiMerge E{GS, A6}; pg8::gemm_phase(lds, S, E); }
    GRID_BAR();
    { pg8::EpiOutLn E{PG, P.in[0], P.out, P.in[19], P.in[20], (unsigned long long*)(ws + OFF_STATS), (unsigned*)(ws + OFF_CTL + 16384), (unsigned*)(ws + OFF_CTL) + XB_TMO};
#pragma unroll 1
      for (int rnd = 0; rnd < 2; ++rnd) {
          pg8::Sched S{(const char*)A6, (const char*)W6, 0, 0, 1280, 1280, 128, 4, 1, 2, 0, 0, 4, 256, 256, 16, G, bid, 0}; S.ui0 = rnd; S.nui = 1;
          pg8::gemm_phase(lds, S, E);
      } }
}

extern "C" void kernel_launch(void* const* d_in, const int* in_sizes, int n_in, void* d_out, int out_size, void* d_ws, size_t ws_size, hipStream_t stream) {
    static int grid = 0;
    if (grid == 0) {
        if (n_in != 21 || out_size != T * 1024 || ws_size < WS_END) { fprintf(stderr, "kernel_launch: unexpected shapes: n_in %d out %d ws %zu (need %zu)\n", n_in, out_size, ws_size, (size_t)WS_END); grid = -1; return; }
        int dev = 0, cus = 0, per_cu = 0;
        (void)hipGetDevice(&dev); (void)hipDeviceGetAttribute(&cus, hipDeviceAttributeMultiprocessorCount, dev);
        if (hipFuncSetAttribute((const void*)mega, hipFuncAttributeMaxDynamicSharedMemorySize, LDS_BYTES) != hipSuccess) { fprintf(stderr, "kernel_launch: hipFuncSetAttribute failed\n"); grid = -1; return; }
        if (hipOccupancyMaxActiveBlocksPerMultiprocessor(&per_cu, (const void*)mega, NTHR, LDS_BYTES) != hipSuccess || per_cu < 1) { fprintf(stderr, "kernel_launch: occupancy query says %d\n", per_cu); per_cu = 1; }
        (void)hipGetLastError();
        grid = cus;
        if (grid != 256) { fprintf(stderr, "kernel_launch: this build needs a 256-CU device (got %d)\n", cus); grid = -1; return; }
    }
    if (grid < 0) return;
    if (hipMemsetAsync((char*)d_ws + OFF_CTL, 0, SZ_CTL, stream) != hipSuccess) { fprintf(stderr, "kernel_launch: memset failed\n"); return; }
    Params p{};
    for (int i = 0; i < 21; ++i) p.in[i] = (const float*)d_in[i];
    p.out = (float*)d_out; p.ws = (unsigned char*)d_ws;
    void* args[] = {&p};
    hipError_t e = hipLaunchCooperativeKernel((const void*)mega, dim3(grid), dim3(NTHR), args, LDS_BYTES, stream);
    if (e != hipSuccess) fprintf(stderr, "cooperative launch failed: %s (grid %d)\n", hipGetErrorString(e), grid);
}
```

```cpp
#include <hip/hip_runtime.h>
#include <hip/hip_cooperative_groups.h>
#include <cstdio>
namespace cg = cooperative_groups;

#define LAS __attribute__((address_space(3)))
typedef unsigned short bf16_t;
typedef short bf16x8 __attribute__((ext_vector_type(8)));
typedef float f32x4 __attribute__((ext_vector_type(4)));
typedef float f32x2 __attribute__((ext_vector_type(2)));
typedef unsigned u32x4 __attribute__((ext_vector_type(4)));

constexpr int T = 32768;
constexpr int NTHR = 512;
constexpr int LDS_STAGE = 131072;
constexpr int LDS_BYTES = LDS_STAGE + 64;
constexpr float ALPHA = 1.189207115002721f;
constexpr float LN_EPS = 1e-5f;

constexpr size_t SZ_XB = (size_t)T * 1024 * 2;
constexpr size_t SZ_YY = (size_t)T * 1536 * 2;
constexpr size_t SZ_A6 = (size_t)T * 1280 * 2;
constexpr size_t SZ_PG = (size_t)T * 1024 * 2;
constexpr size_t SZ_UA = (size_t)32 * 1024 * 640 * 2;
constexpr size_t SZ_WT1 = (size_t)6144 * 1024 * 2;
constexpr size_t SZ_WINP = (size_t)1024 * 1024 * 2;
constexpr size_t SZ_PWT = (size_t)256 * 1024 * 2;
constexpr size_t SZ_GLT = (size_t)512 * 512 * 2;
constexpr size_t SZ_W5 = (size_t)1024 * 1536 * 2;
constexpr size_t SZ_W6 = (size_t)1024 * 1280 * 2;
constexpr size_t SZ_WT2 = (size_t)32 * 256 * 512 * 2;
constexpr size_t SZ_BT3 = (size_t)32 * 512 * 640 * 2;
constexpr size_t SZ_KTAB = (size_t)32 * 32 * 256 * 4;
constexpr size_t SZ_AL = (size_t)32 * 64 * 8;
constexpr size_t SZ_STATS = (size_t)T * 16 * 8;
constexpr size_t OFF_XB = 0;
constexpr size_t OFF_YY = OFF_XB + SZ_XB;
constexpr size_t OFF_A6 = OFF_YY + SZ_YY;
constexpr size_t OFF_PG = OFF_A6 + SZ_A6;
constexpr size_t OFF_UA = OFF_PG + SZ_PG;
constexpr size_t OFF_WT1 = OFF_UA + SZ_UA;
constexpr size_t OFF_WINP = OFF_WT1 + SZ_WT1;
constexpr size_t OFF_PWT = OFF_WINP + SZ_WINP;
constexpr size_t OFF_GLT = OFF_PWT + SZ_PWT;
constexpr size_t OFF_W5 = OFF_GLT + SZ_GLT;
constexpr size_t OFF_W6 = OFF_W5 + SZ_W5;
constexpr size_t OFF_WT2 = OFF_W6 + SZ_W6;
constexpr size_t OFF_BT3 = OFF_WT2 + SZ_WT2;
constexpr size_t OFF_KTAB = OFF_BT3 + SZ_BT3;
constexpr size_t OFF_AL = OFF_KTAB + SZ_KTAB;
constexpr size_t OFF_STATS = OFF_AL + SZ_AL;
constexpr size_t OFF_CTL = OFF_STATS + SZ_STATS;
constexpr size_t SZ_CTL = 65536;
constexpr size_t WS_END = OFF_CTL + SZ_CTL;

struct Params { const float* in[21]; float* out; unsigned char* ws; };

__device__ __forceinline__ int tid_local() { int t = threadIdx.x; asm volatile("" : "+v"(t)); return t; }
typedef __bf16 bf16x2_t __attribute__((ext_vector_type(2)));
__device__ __forceinline__ unsigned cvt_pk_bf16(float lo, float hi) { const f32x2 v = {lo, hi}; return __builtin_bit_cast(unsigned, __builtin_convertvector(v, bf16x2_t)); }
__device__ __forceinline__ u32x4 pack8(f32x4 a, f32x4 b) { u32x4 w; w.x = cvt_pk_bf16(a[0], a[1]); w.y = cvt_pk_bf16(a[2], a[3]); w.z = cvt_pk_bf16(b[0], b[1]); w.w = cvt_pk_bf16(b[2], b[3]); return w; }
__device__ __forceinline__ void unpack8(u32x4 w, f32x4& a, f32x4& b) {
    a[0] = __uint_as_float(w.x << 16); a[1] = __uint_as_float(w.x & 0xffff0000u); a[2] = __uint_as_float(w.y << 16); a[3] = __uint_as_float(w.y & 0xffff0000u);
    b[0] = __uint_as_float(w.z << 16); b[1] = __uint_as_float(w.z & 0xffff0000u); b[2] = __uint_as_float(w.w << 16); b[3] = __uint_as_float(w.w & 0xffff0000u); }
__device__ __forceinline__ float sigm(float x) { return __builtin_amdgcn_rcpf(1.0f + __expf(-x)); }
__device__ __forceinline__ f32x4 sigm4(f32x4 v) { f32x4 r; r[0] = sigm(v[0]); r[1] = sigm(v[1]); r[2] = sigm(v[2]); r[3] = sigm(v[3]); return r; }
__device__ __forceinline__ f32x4 gelu4(f32x4 v) {
    const f32x4 u = v * ((v * v) * (-0.10294324f) + (-2.3022082f)); f32x4 r;
#pragma unroll
    for (int e = 0; e < 4; ++e) r[e] = v[e] * __builtin_amdgcn_rcpf(1.0f + __builtin_amdgcn_exp2f(u[e]));
    return r; }


#define XB_TMO      128
#define XB_XCNT(j)  (256  + 64 * (j))
#define XB_XSUB(j)  (1280 + 64 * (j))
#define XB_XGEN(j)  (2304 + 64 * (j))
#define XB_TOP      3328
#define XB_TOPGEN   3392
#define XCD_BAR_WORDS 3456
#define XB_SPIN_CAP (1u << 22)
__device__ __forceinline__ unsigned xb_ld(unsigned* p)              { return __hip_atomic_load(p, __ATOMIC_RELAXED, __HIP_MEMORY_SCOPE_AGENT); }
__device__ __forceinline__ unsigned xb_add(unsigned* p, unsigned v) { return __hip_atomic_fetch_add(p, v, __ATOMIC_RELAXED, __HIP_MEMORY_SCOPE_AGENT); }
__device__ __forceinline__ unsigned xb_xcc_id() { return (unsigned)__builtin_amdgcn_s_getreg((3 << 11) | 20) & 0xFu; }
#define XB_SPIN(cond, bar) do { unsigned _sp = 0; while (cond) { __builtin_amdgcn_s_sleep(1); \
    if ((++_sp & 255u) == 0u) { if (xb_ld(&(bar)[XB_TMO])) break; if (_sp > XB_SPIN_CAP) { atomicAdd(&(bar)[XB_TMO], 1u); break; } } } } while (0)
struct XcdBarrier { unsigned* bar; unsigned x; volatile LAS unsigned* st; };
__device__ __forceinline__ XcdBarrier xcd_barrier_post(unsigned* bar, volatile LAS unsigned* st) {
    XcdBarrier b; b.bar = bar; b.x = xb_xcc_id(); b.st = st;
    if (threadIdx.x == 0) (void)xb_add(&bar[XB_XCNT(b.x)], 1u);
    return b;
}
__device__ __forceinline__ void xcd_barrier_complete(unsigned* bar, unsigned x, unsigned& nloc, unsigned& nx) {
    const unsigned G = gridDim.x * gridDim.y * gridDim.z;
    unsigned sum, cnt, mine, sp = 0u;
    for (;;) {
        sum = 0u; cnt = 0u; mine = 0u;
#pragma unroll
        for (unsigned j = 0; j < 16; ++j) { const unsigned c = xb_ld(&bar[XB_XCNT(j)]); sum += c; cnt += (c > 0u) ? 1u : 0u; mine = (j == x) ? c : mine; }
        if (sum == G) break;
        __builtin_amdgcn_s_sleep(1);
        if ((++sp & 255u) == 0u) { if (xb_ld(&bar[XB_TMO])) break; if (sp > XB_SPIN_CAP) { atomicAdd(&bar[XB_TMO], 1u); break; } }
    }
    nloc = mine > 0u ? mine : 1u; nx = cnt > 0u ? cnt : 1u;
}
__device__ __forceinline__ void xcd_barrier(const XcdBarrier& b) {
    asm volatile("s_waitcnt vmcnt(0)" ::: "memory");
    __syncthreads();
    if (threadIdx.x == 0) {
        unsigned* bar = b.bar;
        __builtin_amdgcn_s_waitcnt(0);
        unsigned nloc = b.st[0], nx = b.st[1];
        if (nloc == 0u) { xcd_barrier_complete(bar, b.x, nloc, nx); b.st[0] = nloc; b.st[1] = nx; }
        const unsigned old = xb_add(&bar[XB_XSUB(b.x)], 1u);
        const unsigned gen = old / nloc;
        if (old + 1u == (gen + 1u) * nloc) {
            __builtin_amdgcn_fence(__ATOMIC_RELEASE, "agent");
            asm volatile("s_waitcnt vmcnt(0)" ::: "memory");
            const unsigned og = xb_add(&bar[XB_TOP], 1u);
            const unsigned tg = og / nx;
            if (og + 1u == (tg + 1u) * nx) xb_add(&bar[XB_TOPGEN], 1u);
            else XB_SPIN(xb_ld(&bar[XB_TOPGEN]) == tg, bar);
            __builtin_amdgcn_fence(__ATOMIC_ACQUIRE, "agent");
            xb_add(&bar[XB_XGEN(b.x)], 1u);
            asm volatile("s_waitcnt vmcnt(0)" ::: "memory");
        } else {
            XB_SPIN(xb_ld(&bar[XB_XGEN(b.x)]) == gen, bar);
            __builtin_amdgcn_fence(__ATOMIC_ACQUIRE, "agent");
            asm volatile("s_waitcnt vmcnt(0)" ::: "memory");
        }
    }
    __syncthreads();
}

namespace pg8 {
constexpr int BM = 256, BK = 64, HALF = 128, HTB = HALF * BK * 2, NXCD = 8, WGM = 8;
__device__ __forceinline__ int lds_byte(int r, int c) { const int st = (r >> 4) * 2 + (c >> 5), rr = r & 15, cc = c & 31, ob = rr * 64 + cc * 2; return st * 1024 + (ob ^ (((ob >> 9) & 1) << 5)); }
__device__ __forceinline__ void stage_rc(int b, int& R, int& C) { const int st = b / 1024, sb = b % 1024, swz = sb ^ (((sb >> 9) & 1) << 5); R = (st >> 1) * 16 + swz / 64; C = (st & 1) * 32 + (swz % 64) / 2; }
__device__ __forceinline__ int perm32(int rho) { const int n = rho >> 4, i = rho & 15; return 8 * (i >> 2) + 4 * n + (i & 3); }

struct Seg { const char* A; const char* B; int nt, fin, pm, pn, g; };

struct Sched {
    const char* A; const char* B; size_t gsA, gsB;
    int lda, ldb;
    int nM, nN, nG;
    int nseg, ka0, kb0, nt0, ka1, kb1, nt1;
    int G, c, mode;
    int ui0 = 0, nui = 1 << 30;
    __device__ __forceinline__ bool next(int i, Seg& s) const {
        const int ur = (nseg == 2) ? (i >> 1) : i, si = (nseg == 2) ? (i & 1) : 0; if (ur >= nui) return false; const int ui = ui0 + ur;
        const int nwg = nM * nN * nG; const long L = (long)ui * G + c; if (L >= nwg) return false;
        int g = 0, pm, pn;
        if (mode == 0) {
            int wgid = (int)L; { const int q = nwg / NXCD, r = nwg % NXCD, xcd = wgid % NXCD, off = wgid / NXCD; wgid = (xcd < r ? xcd * (q + 1) : r * (q + 1) + (xcd - r) * q) + off; }
            const int nig = WGM * nN, gid = wgid / nig, fm = gid * WGM, gsz = (nM - fm) < WGM ? (nM - fm) : WGM;
            pm = fm + ((wgid % nig) % gsz); pn = (wgid % nig) / gsz;
        } else { const int per = nM * nN; g = (int)L / per; const int rem = (int)L % per; pm = rem / nN; pn = rem % nN; }
        const int ka = si ? ka1 : ka0, kb = si ? kb1 : kb0;
        s.A = A + (size_t)g * gsA + ((size_t)pm * BM * lda + ka) * 2; s.B = B + (size_t)g * gsB + ((size_t)pn * BM * ldb + kb) * 2;
        s.nt = si ? nt1 : nt0; s.fin = (si == nseg - 1) ? 1 : 0; s.pm = pm; s.pn = pn; s.g = g; return true;
    }
};

typedef f32x4 Acc[2][2][4][2];
#define EPI_ROWS(s) _Pragma("unroll") for (int ai = 0; ai < 2; ++ai) _Pragma("unroll") for (int m = 0; m < 4; ++m)
#define EPI_FENCE() do { if (m == 3) asm volatile("" ::: "memory"); } while (0)
#define EPI_R(s) ((s).pm * 256 + ai * 128 + wr * 64 + m * 16 + fr)
#define EPI_C(s, bj) ((s).pn * 256 + wc * 64 + (bj) * 32 + fq * 8)

template <class Epi>
__device__ __forceinline__ void gemm_phase(LAS unsigned char* lds, const Sched& S, const Epi& E) {
    const int tid = tid_local(), wid = __builtin_amdgcn_readfirstlane(tid >> 6), lane = tid & 63, wr = wid >> 2, wc = wid & 3, fr = lane & 15, fq = lane >> 4;
    const int lda = S.lda, ldb = S.ldb;
    unsigned voffA[2], voffB[2];
#pragma unroll
    for (int i = 0; i < 2; ++i) { int R, C; stage_rc(tid * 16 + i * 8192, R, C); const int Rb = (R >> 5) * 64 + perm32(R & 31);
        voffA[i] = (unsigned)(R * lda + C) * 2u; voffB[i] = (unsigned)(Rb * ldb + C) * 2u; }
    const size_t kstep = (size_t)(BK * 2);
    const size_t hstepA = (size_t)HALF * lda * 2, hstepB = (size_t)32 * ldb * 2;
    const unsigned ldsw = (unsigned)wid * 1024u;
    const int aoff = lds_byte(wr * 64 + fr, fq * 8), boff = lds_byte(wc * 32 + fr, fq * 8);
#define PG8_SA(b, h) (((b) * 2 + (h)) * HTB)
#define PG8_SB(b, h) ((4 + (b) * 2 + (h)) * HTB)
#define PG8_STAGE(bufoff, gbase, voff) do { _Pragma("unroll") for (int _i = 0; _i < 2; ++_i) \
        __builtin_amdgcn_global_load_lds((const unsigned*)((const char*)(gbase) + (voff)[_i]), (LAS unsigned*)(lds + (bufoff) + ldsw + _i * 8192), 16, 0, 0); } while (0)
#define PG8_LDA(dst, b, h) do { _Pragma("unroll") for (int m = 0; m < 4; ++m) _Pragma("unroll") for (int k = 0; k < 2; ++k) dst[m][k] = *(const LAS bf16x8*)(lds + PG8_SA(b, h) + aoff + m * 2048 + k * 1024); } while (0)
#define PG8_LDB(dst, b, h) do { _Pragma("unroll") for (int n = 0; n < 2; ++n) _Pragma("unroll") for (int k = 0; k < 2; ++k) dst[n][k] = *(const LAS bf16x8*)(lds + PG8_SB(b, h) + boff + n * 2048 + k * 1024); } while (0)
#define PG8_MMA(ai, bj, At, Bt) do { __builtin_amdgcn_s_setprio(1); _Pragma("unroll") for (int m = 0; m < 4; ++m) _Pragma("unroll") for (int n = 0; n < 2; ++n) _Pragma("unroll") for (int k = 0; k < 2; ++k) \
        acc[ai][bj][m][n] = __builtin_amdgcn_mfma_f32_16x16x32_bf16(Bt[n][k], At[m][k], acc[ai][bj][m][n], 0, 0, 0); __builtin_amdgcn_s_setprio(0); } while (0)
#define PG8_WAIT_V(n) asm volatile("s_waitcnt vmcnt(" #n ")" ::: "memory")
#define PG8_WAIT_L(n) asm volatile("s_waitcnt lgkmcnt(" #n ")" ::: "memory")
#define PG8_BAR __builtin_amdgcn_s_barrier()
#define PG8_SCHED __builtin_amdgcn_sched_barrier(0)
#define PG8_ZERO() do { _Pragma("unroll") for (int a = 0; a < 2; ++a) _Pragma("unroll") for (int b = 0; b < 2; ++b) _Pragma("unroll") for (int m = 0; m < 4; ++m) _Pragma("unroll") for (int n = 0; n < 2; ++n) acc[a][b][m][n] = (f32x4){0.f, 0.f, 0.f, 0.f}; } while (0)
    Seg cur, nxt; int ui = 0;
    if (!S.next(0, cur)) return;
    Acc acc;
    PG8_ZERO();
    bf16x8 At[4][2], B0[2][2], B1[2][2];
    const char* cA = cur.A; const char* cB = cur.B; int nt = cur.nt;
    PG8_STAGE(PG8_SB(0, 0), cB, voffB); PG8_STAGE(PG8_SA(0, 0), cA, voffA); PG8_STAGE(PG8_SB(0, 1), cB + hstepB, voffB); PG8_STAGE(PG8_SA(0, 1), cA + hstepA, voffA);
    if (wr == 1) PG8_BAR;
    PG8_WAIT_V(4); PG8_BAR;
    PG8_STAGE(PG8_SB(1, 0), cB + kstep, voffB); PG8_STAGE(PG8_SA(1, 0), cA + kstep, voffA); PG8_STAGE(PG8_SB(1, 1), cB + hstepB + kstep, voffB);
    PG8_WAIT_V(6); PG8_BAR;
    for (;;) {
        const bool has_next = S.next(ui + 1, nxt);
        const char* nA = has_next ? nxt.A : cA; const char* nB = has_next ? nxt.B : cB;
        for (int t = 0; t < nt; t += 2) {
            const bool last = (t == nt - 2);
            const char* a1 = cA + (size_t)(t + 1) * kstep;
            const char* a2 = last ? nA : cA + (size_t)(t + 2) * kstep; const char* b2 = last ? nB : cB + (size_t)(t + 2) * kstep;
            const char* a3 = a2 + kstep; const char* b3 = b2 + kstep;
            PG8_LDB(B0, 0, 0); PG8_SCHED; PG8_LDA(At, 0, 0); PG8_STAGE(PG8_SA(1, 1), a1 + hstepA, voffA);
            PG8_WAIT_L(8); PG8_BAR; PG8_WAIT_L(0); PG8_MMA(0, 0, At, B0); PG8_BAR; PG8_SCHED;
            PG8_LDB(B1, 0, 1); PG8_STAGE(PG8_SB(0, 0), b2, voffB);
            PG8_BAR; PG8_WAIT_L(0); PG8_MMA(0, 1, At, B1); PG8_BAR;
            PG8_LDA(At, 0, 1); PG8_STAGE(PG8_SA(0, 0), a2, voffA);
            PG8_BAR; PG8_WAIT_L(0); PG8_MMA(1, 0, At, B0); PG8_BAR; PG8_SCHED;
            PG8_STAGE(PG8_SB(0, 1), b2 + hstepB, voffB);
            PG8_WAIT_V(6); PG8_BAR; PG8_MMA(1, 1, At, B1); PG8_BAR;
            PG8_LDB(B0, 1, 0); PG8_SCHED; PG8_LDA(At, 1, 0); PG8_STAGE(PG8_SA(0, 1), a2 + hstepA, voffA);
            PG8_WAIT_L(8); PG8_BAR; PG8_WAIT_L(0); PG8_MMA(0, 0, At, B0); PG8_BAR; PG8_SCHED;
            PG8_LDB(B1, 1, 1); PG8_STAGE(PG8_SB(1, 0), b3, voffB);
            PG8_BAR; PG8_WAIT_L(0); PG8_MMA(0, 1, At, B1); PG8_BAR;
            PG8_LDA(At, 1, 1); PG8_STAGE(PG8_SA(1, 0), a3, voffA);
            PG8_BAR; PG8_WAIT_L(0); PG8_MMA(1, 0, At, B0); PG8_BAR; PG8_SCHED;
            PG8_STAGE(PG8_SB(1, 1), b3 + hstepB, voffB);
            PG8_WAIT_V(6); PG8_BAR; PG8_MMA(1, 1, At, B1); PG8_BAR;
        }
        if (cur.fin) { if constexpr (!Epi::AFTER_DRAIN) E.fin(acc, cur, wr, wc, fr, fq); }
        else E.mid(acc, cur, wr, wc, fr, fq);
        if (!has_next) break;
        if (cur.fin) PG8_ZERO();
        cur = nxt; cA = nA; cB = nB; nt = cur.nt; ++ui;
    }
    PG8_WAIT_V(0);
    if (wr == 0) PG8_BAR;
    PG8_BAR;
    if constexpr (Epi::AFTER_DRAIN) E.fused(acc, cur, wr, wc, fr, fq, lds);
#undef PG8_SA
#undef PG8_SB
#undef PG8_STAGE
#undef PG8_LDA
#undef PG8_LDB
#undef PG8_MMA
#undef PG8_WAIT_V
#undef PG8_WAIT_L
#undef PG8_BAR
#undef PG8_SCHED
#undef PG8_ZERO
}

struct EpiFold {
    static constexpr bool AFTER_DRAIN = false;
    bf16_t* WT1;
    __device__ __forceinline__ void mid(Acc&, const Seg&, int, int, int, int) const {}
    __device__ __forceinline__ void fin(Acc& acc, const Seg& s, int wr, int wc, int fr, int fq) const {
        EPI_ROWS(s) { const int r = EPI_R(s);
#pragma unroll
            for (int bj = 0; bj < 2; ++bj) { const int c = EPI_C(s, bj); *(u32x4*)(WT1 + (size_t)(s.g * 256 + r) * 1024 + c) = pack8(acc[ai][bj][m][0], acc[ai][bj][m][1]); } }
    }
};
struct EpiProj {
    static constexpr bool AFTER_DRAIN = false;
    bf16_t *Z, *YY, *UA, *A6, *GS, *PG;
    __device__ __forceinline__ void mid(Acc&, const Seg&, int, int, int, int) const {}
    __device__ __forceinline__ void fin(Acc& acc, const Seg& s, int wr, int wc, int fr, int fq) const {
        const int pn = s.pn;
        if (pn == 8 || pn == 9) {
            EPI_ROWS(s) { const int r = EPI_R(s);
#pragma unroll
                for (int bj = 0; bj < 2; ++bj) { const int c = (pn - 8) * 256 + wc * 64 + bj * 32 + fq * 8; const int g = c >> 4, h0 = c & 15;
                    __builtin_nontemporal_store(pack8(acc[ai][bj][m][0], acc[ai][bj][m][1]), (u32x4*)(UA + (size_t)g * (1024 * 640) + (size_t)(r >> 5) * 640 + (r & 31) * 16 + h0)); } }
            return;
        }
        if (pn >= 12 && pn < 20) {
            const int cp = (pn - 12) * 128 + wc * 32 + fq * 8;
            EPI_ROWS(s) { const int r = EPI_R(s); f32x4 p0 = acc[ai][0][m][0], p1 = acc[ai][0][m][1], q0 = acc[ai][1][m][0], q1 = acc[ai][1][m][1];
#pragma unroll
                for (int e = 0; e < 4; ++e) { p0[e] = 1.0f + __builtin_amdgcn_exp2f(p0[e]); p1[e] = 1.0f + __builtin_amdgcn_exp2f(p1[e]);
                    q0[e] = p0[e] * __builtin_amdgcn_rcpf(1.0f + __builtin_amdgcn_exp2f(q0[e])); q1[e] = p1[e] * __builtin_amdgcn_rcpf(1.0f + __builtin_amdgcn_exp2f(q1[e])); }
                __builtin_nontemporal_store(pack8(p0, p1), (u32x4*)(A6 + (size_t)r * 1280 + 256 + cp)); __builtin_nontemporal_store(pack8(q0, q1), (u32x4*)(GS + (size_t)r * 1024 + cp)); }
            return;
        }
        bf16_t* base; int ld, c0, act;
        if (pn < 4) { base = Z; ld = 1024; c0 = pn * 256; act = 0; }
        else if (pn < 8) { base = YY + 512; ld = 1536; c0 = (pn - 4) * 256; act = 0; }
        else if (pn < 12) { base = YY; ld = 1536; c0 = (pn - 10) * 256; act = 0; }
        else { base = PG; ld = 1024; c0 = (pn - 20) * 256; act = 2; }
        if (act == 0) {
            EPI_ROWS(s) { const int r = EPI_R(s);
#pragma unroll
                for (int bj = 0; bj < 2; ++bj) { const int c = c0 + wc * 64 + bj * 32 + fq * 8; __builtin_nontemporal_store(pack8(acc[ai][bj][m][0], acc[ai][bj][m][1]), (u32x4*)(base + (size_t)r * ld + c)); }
                }
        } else {
            EPI_ROWS(s) { const int r = EPI_R(s);
#pragma unroll
                for (int bj = 0; bj < 2; ++bj) { const int c = c0 + wc * 64 + bj * 32 + fq * 8; f32x4 v0, v1;
#pragma unroll
                    for (int e = 0; e < 4; ++e) { v0[e] = __builtin_amdgcn_rcpf(1.0f + __builtin_amdgcn_exp2f(acc[ai][bj][m][0][e])); v1[e] = __builtin_amdgcn_rcpf(1.0f + __builtin_amdgcn_exp2f(acc[ai][bj][m][1][e])); }
                    __builtin_nontemporal_store(pack8(v0, v1), (u32x4*)(base + (size_t)r * ld + c)); }
                }
        }
    }
};
struct EpiState {
    static constexpr bool AFTER_DRAIN = true;
    bf16_t* UA; const f32x2* AL;
    __device__ __forceinline__ void mid(Acc&, const Seg&, int, int, int, int) const {}
    __device__ __forceinline__ void fin(Acc&, const Seg&, int, int, int, int) const {}
    __device__ __forceinline__ void fused(Acc& acc, const Seg& s, int wr, int wc, int fr, int fq, LAS unsigned char* lds) const {
        LAS float* Sl = (LAS float*)lds;
        if (wc < 2) {
            EPI_ROWS(s) { const int rl = ai * 128 + wr * 64 + m * 16 + fr;
#pragma unroll
                for (int bj = 0; bj < 2; ++bj) { const int c = wc * 64 + bj * 32 + fq * 8; *(LAS f32x4*)(Sl + rl * 128 + c) = acc[ai][bj][m][0]; *(LAS f32x4*)(Sl + rl * 128 + c + 4) = acc[ai][bj][m][1]; } } }
        __syncthreads();
        const int tid = tid_local(), bl = tid >> 6, p = tid & 63;
        if (bl < 4) {
            const f32x2 al = AL[s.g * 64 + p];
            float er = 0.f, ei = 0.f;
            bf16_t* dst = UA + (size_t)s.g * (1024 * 640) + (size_t)(s.pm * 256 + bl * 64) * 640 + 512 + p;
            for (int c = 0; c < 64; ++c) {
                const float sr = Sl[(bl * 64 + c) * 128 + p], si = Sl[(bl * 64 + c) * 128 + 64 + p];
                const unsigned w = cvt_pk_bf16(er, ei);
                dst[(size_t)c * 640] = (bf16_t)(w & 0xffffu); dst[(size_t)c * 640 + 64] = (bf16_t)(w >> 16);
                const float nr = al.x * er - al.y * ei + sr, ni = al.x * ei + al.y * er + si; er = nr; ei = ni;
            }
        }
        __syncthreads();
    }
};
struct EpiS5Out {
    static constexpr bool AFTER_DRAIN = false;
    const bf16_t* __restrict__ UA; const float* __restrict__ dskip; bf16_t* __restrict__ GY;
    __device__ __forceinline__ void mid(Acc&, const Seg&, int, int, int, int) const {}
    __device__ __forceinline__ void fin(Acc& acc, const Seg& s, int wr, int wc, int fr, int fq) const {
        f32x4 d0[2], d1[2];
#pragma unroll
        for (int bj = 0; bj < 2; ++bj) { const int h0 = EPI_C(s, bj) & 15; d0[bj] = *(const f32x4*)(dskip + s.g * 16 + h0); d1[bj] = *(const f32x4*)(dskip + s.g * 16 + h0 + 4); }
#pragma unroll
        for (int ai = 0; ai < 2; ++ai) {
            u32x4 uw[4][2];
#pragma unroll
            for (int m = 0; m < 4; ++m)
#pragma unroll
                for (int bj = 0; bj < 2; ++bj) uw[m][bj] = *(const u32x4*)(UA + (size_t)s.g * (1024 * 640) + (size_t)EPI_R(s) * 640 + EPI_C(s, bj));
#pragma unroll
            for (int m = 0; m < 4; ++m) { const int R = EPI_R(s);
#pragma unroll
                for (int bj = 0; bj < 2; ++bj) { const int c = EPI_C(s, bj); const int t = c >> 4, h0 = c & 15; f32x4 u0, u1; unpack8(uw[m][bj], u0, u1);
                    const f32x4 v0 = gelu4(acc[ai][bj][m][0] + d0[bj] * u0), v1 = gelu4(acc[ai][bj][m][1] + d1[bj] * u1);
                    *(u32x4*)(GY + (size_t)(R * 32 + t) * 512 + s.g * 16 + h0) = pack8(v0, v1); } }
            asm volatile("" ::: "memory");
        }
    }
};
struct EpiGlu {
    static constexpr bool AFTER_DRAIN = false;
    const bf16_t* __restrict__ GY; const float* __restrict__ bias; bf16_t* YY;
    __device__ __forceinline__ void mid(Acc&, const Seg&, int, int, int, int) const {}
    __device__ __forceinline__ void fin(Acc& acc, const Seg& s, int wr, int wc, int fr, int fq) const {
        f32x4 b0[2], b1[2];
#pragma unroll
        for (int bj = 0; bj < 2; ++bj) { const int c = EPI_C(s, bj); b0[bj] = *(const f32x4*)(bias + c); b1[bj] = *(const f32x4*)(bias + c + 4); }
#pragma unroll
        for (int aim = 0; aim < 4; ++aim) { const int ai = aim >> 1, mh = aim & 1;
            u32x4 gw[2][2], sw[2][2];
#pragma unroll
            for (int mm = 0; mm < 2; ++mm)
#pragma unroll
                for (int bj = 0; bj < 2; ++bj) { const int m = mh * 2 + mm; const int r = EPI_R(s), c = EPI_C(s, bj); gw[mm][bj] = *(const u32x4*)(GY + (size_t)r * 512 + c); sw[mm][bj] = *(const u32x4*)(YY + (size_t)r * 1536 + c); }
#pragma unroll
            for (int mm = 0; mm < 2; ++mm)
#pragma unroll
                for (int bj = 0; bj < 2; ++bj) { const int m = mh * 2 + mm; const int r = EPI_R(s), c = EPI_C(s, bj); f32x4 g0, g1, s0, s1; unpack8(gw[mm][bj], g0, g1); unpack8(sw[mm][bj], s0, s1); s0 = s0 * sigm4(s0); s1 = s1 * sigm4(s1);
                    const f32x4 v0 = g0 * sigm4(acc[ai][bj][m][0] + b0[bj]) * s0, v1 = g1 * sigm4(acc[ai][bj][m][1] + b1[bj]) * s1;
                    *(u32x4*)(YY + (size_t)r * 1536 + c) = pack8(v0, v1); }
            asm volatile("" ::: "memory");
        }
    }
};
struct EpiMerge {
    static constexpr bool AFTER_DRAIN = false;
    const bf16_t* __restrict__ GS; bf16_t* A6;
    __device__ __forceinline__ void mid(Acc& acc, const Seg& s, int wr, int wc, int fr, int fq) const {
#pragma unroll
        for (int ai = 0; ai < 2; ++ai) {
            u32x4 aw[4][2];
#pragma unroll
            for (int m = 0; m < 4; ++m)
#pragma unroll
                for (int bj = 0; bj < 2; ++bj) aw[m][bj] = *(const u32x4*)(GS + (size_t)EPI_R(s) * 1024 + EPI_C(s, bj));
#pragma unroll
            for (int m = 0; m < 4; ++m)
#pragma unroll
                for (int bj = 0; bj < 2; ++bj) { f32x4 a0, a1; unpack8(aw[m][bj], a0, a1); acc[ai][bj][m][0] *= a0; acc[ai][bj][m][1] *= a1; }
            asm volatile("" ::: "memory");
        }
    }
    __device__ __forceinline__ void fin(Acc& acc, const Seg& s, int wr, int wc, int fr, int fq) const {
#pragma unroll
        for (int ai = 0; ai < 2; ++ai) {
            u32x4 bw[4][2];
#pragma unroll
            for (int m = 0; m < 4; ++m)
#pragma unroll
                for (int bj = 0; bj < 2; ++bj) bw[m][bj] = *(const u32x4*)(A6 + (size_t)EPI_R(s) * 1280 + 256 + EPI_C(s, bj));
#pragma unroll
            for (int m = 0; m < 4; ++m)
#pragma unroll
                for (int bj = 0; bj < 2; ++bj) { f32x4 b0, b1; unpack8(bw[m][bj], b0, b1);
#pragma unroll
                    for (int e = 0; e < 4; ++e) { b0[e] = __builtin_amdgcn_rcpf(b0[e]); b1[e] = __builtin_amdgcn_rcpf(b1[e]); }
                    *(u32x4*)(A6 + (size_t)EPI_R(s) * 1280 + 256 + EPI_C(s, bj)) = pack8(acc[ai][bj][m][0] * b0, acc[ai][bj][m][1] * b1); }
            asm volatile("" ::: "memory");
        }
    }
};
struct EpiOut {
    static constexpr bool AFTER_DRAIN = false;
    const bf16_t* __restrict__ PG; const float* __restrict__ x; float* __restrict__ out; f32x2* __restrict__ stats;
    __device__ __forceinline__ void mid(Acc& acc, const Seg& s, int wr, int wc, int fr, int fq) const {
#pragma unroll
        for (int ai = 0; ai < 2; ++ai) {
            u32x4 aw[4][2];
#pragma unroll
            for (int m = 0; m < 4; ++m)
#pragma unroll
                for (int bj = 0; bj < 2; ++bj) aw[m][bj] = *(const u32x4*)(PG + (size_t)EPI_R(s) * 1024 + EPI_C(s, bj));
#pragma unroll
            for (int m = 0; m < 4; ++m)
#pragma unroll
                for (int bj = 0; bj < 2; ++bj) { f32x4 a0, a1; unpack8(aw[m][bj], a0, a1); acc[ai][bj][m][0] *= a0; acc[ai][bj][m][1] *= a1; }
            asm volatile("" ::: "memory");
        }
    }
    __device__ __forceinline__ void fin(Acc& acc, const Seg& s, int wr, int wc, int fr, int fq) const {
#pragma unroll
        for (int aim = 0; aim < 4; ++aim) { const int ai = aim >> 1, mh = aim & 1;
            f32x4 xv[2][2][2];
#pragma unroll
            for (int mm = 0; mm < 2; ++mm)
#pragma unroll
                for (int bj = 0; bj < 2; ++bj) { const int m = mh * 2 + mm; const float* xp = x + (size_t)EPI_R(s) * 1024 + EPI_C(s, bj); xv[mm][bj][0] = __builtin_nontemporal_load((const f32x4*)xp); xv[mm][bj][1] = __builtin_nontemporal_load((const f32x4*)(xp + 4)); }
#pragma unroll
            for (int mm = 0; mm < 2; ++mm) { const int m = mh * 2 + mm; const int r = EPI_R(s); float s1 = 0.f, s2 = 0.f;
#pragma unroll
                for (int bj = 0; bj < 2; ++bj) { float* op = out + (size_t)r * 1024 + EPI_C(s, bj);
                    const f32x4 h0 = xv[mm][bj][0] * ALPHA + acc[ai][bj][m][0], h1 = xv[mm][bj][1] * ALPHA + acc[ai][bj][m][1];
                    *(f32x4*)op = h0; *(f32x4*)(op + 4) = h1;
                    s1 += (h0[0] + h0[1]) + (h0[2] + h0[3]) + (h1[0] + h1[1]) + (h1[2] + h1[3]);
                    s2 += (h0[0] * h0[0] + h0[1] * h0[1]) + (h0[2] * h0[2] + h0[3] * h0[3]) + (h1[0] * h1[0] + h1[1] * h1[1]) + (h1[2] * h1[2] + h1[3] * h1[3]); }
                s1 += __shfl_xor(s1, 16); s1 += __shfl_xor(s1, 32); s2 += __shfl_xor(s2, 16); s2 += __shfl_xor(s2, 32);
                if (fq == 0) stats[(size_t)r * 16 + s.pn * 4 + wc] = (f32x2){s1, s2}; }
            asm volatile("" ::: "memory");
        }
    }
};
struct EpiOutLn {
    static constexpr bool AFTER_DRAIN = true;
    const bf16_t* __restrict__ PG; const float* __restrict__ x; float* __restrict__ out; const float* __restrict__ lg; const float* __restrict__ lb;
    unsigned long long* xbuf; unsigned* cnt; unsigned* tmo;
    __device__ __forceinline__ void mid(Acc& acc, const Seg& s, int wr, int wc, int fr, int fq) const {
#pragma unroll
        for (int ai = 0; ai < 2; ++ai) {
            u32x4 aw[4][2];
#pragma unroll
            for (int m = 0; m < 4; ++m)
#pragma unroll
                for (int bj = 0; bj < 2; ++bj) aw[m][bj] = *(const u32x4*)(PG + (size_t)EPI_R(s) * 1024 + EPI_C(s, bj));
#pragma unroll
            for (int m = 0; m < 4; ++m)
#pragma unroll
                for (int bj = 0; bj < 2; ++bj) { f32x4 a0, a1; unpack8(aw[m][bj], a0, a1); acc[ai][bj][m][0] *= a0; acc[ai][bj][m][1] *= a1; }
            asm volatile("" ::: "memory");
        }
    }
    __device__ __forceinline__ void fin(Acc&, const Seg&, int, int, int, int) const {}
    __device__ __forceinline__ void fused(Acc& acc, const Seg& s, int wr, int wc, int fr, int fq, LAS unsigned char* lds) const {
        LAS f32x2* Pt = (LAS f32x2*)lds;
        LAS f32x2* St = (LAS f32x2*)(lds + 8192);
        const int tl = tid_local(), wid = tl >> 6, lane = tl & 63;
#pragma unroll
        for (int aim = 0; aim < 4; ++aim) { const int ai = aim >> 1, mh = aim & 1;
            f32x4 xv[2][2][2];
#pragma unroll
            for (int mm = 0; mm < 2; ++mm)
#pragma unroll
                for (int bj = 0; bj < 2; ++bj) { const int m = mh * 2 + mm; const float* xp = x + (size_t)EPI_R(s) * 1024 + EPI_C(s, bj); xv[mm][bj][0] = __builtin_nontemporal_load((const f32x4*)xp); xv[mm][bj][1] = __builtin_nontemporal_load((const f32x4*)(xp + 4)); }
#pragma unroll
            for (int mm = 0; mm < 2; ++mm) { const int m = mh * 2 + mm; float s1 = 0.f, s2 = 0.f;
#pragma unroll
                for (int bj = 0; bj < 2; ++bj) { const f32x4 h0 = xv[mm][bj][0] * ALPHA + acc[ai][bj][m][0], h1 = xv[mm][bj][1] * ALPHA + acc[ai][bj][m][1];
                    acc[ai][bj][m][0] = h0; acc[ai][bj][m][1] = h1;
                    s1 += (h0[0] + h0[1]) + (h0[2] + h0[3]) + (h1[0] + h1[1]) + (h1[2] + h1[3]);
                    s2 += (h0[0] * h0[0] + h0[1] * h0[1]) + (h0[2] * h0[2] + h0[3] * h0[3]) + (h1[0] * h1[0] + h1[1] * h1[1]) + (h1[2] * h1[2] + h1[3] * h1[3]); }
                s1 += __shfl_xor(s1, 16); s1 += __shfl_xor(s1, 32); s2 += __shfl_xor(s2, 16); s2 += __shfl_xor(s2, 32);
                if (fq == 0) Pt[(ai * 128 + wr * 64 + m * 16 + fr) * 4 + wc] = (f32x2){s1, s2}; }
            asm volatile("" ::: "memory"); __builtin_amdgcn_sched_barrier(0);
        }
        __syncthreads();
        const int row = wid * 32 + (lane & 31);
        if (lane < 32) { const f32x2 a = Pt[row * 4 + 0], b = Pt[row * 4 + 1], c = Pt[row * 4 + 2], d = Pt[row * 4 + 3];
            const float t1 = (a.x + b.x) + (c.x + d.x), t2 = (a.y + b.y) + (c.y + d.y);
            __hip_atomic_store(xbuf + ((size_t)(s.pm * 256 + row) * 4 + s.pn), ((unsigned long long)__float_as_uint(t2) << 32) | __float_as_uint(t1), __ATOMIC_RELAXED, __HIP_MEMORY_SCOPE_AGENT); }
        asm volatile("s_waitcnt vmcnt(0)" ::: "memory");
        if (lane == 0) __hip_atomic_fetch_add(cnt + 64 * s.pm, 1u, __ATOMIC_RELAXED, __HIP_MEMORY_SCOPE_AGENT);
        if (wid == 0) { unsigned sp = 0;
            while ((unsigned)__builtin_amdgcn_readfirstlane(__hip_atomic_load(cnt + 64 * s.pm, __ATOMIC_RELAXED, __HIP_MEMORY_SCOPE_AGENT)) < 32u) {
                __builtin_amdgcn_s_sleep(1);
                if ((++sp & 255u) == 0u) { if (xb_ld(tmo)) break; if (sp > XB_SPIN_CAP) { if (lane == 0) atomicAdd(tmo, 1u); break; } } }
            __builtin_amdgcn_fence(__ATOMIC_ACQUIRE, "agent"); }
        asm volatile("s_waitcnt vmcnt(0) lgkmcnt(0)" ::: "memory");
        __syncthreads();
        if (lane < 32) { float t1 = 0.f, t2 = 0.f;
#pragma unroll
            for (int t = 0; t < 4; ++t) { const unsigned long long w = __hip_atomic_load(xbuf + ((size_t)(s.pm * 256 + row) * 4 + t), __ATOMIC_RELAXED, __HIP_MEMORY_SCOPE_AGENT); t1 += __uint_as_float((unsigned)w); t2 += __uint_as_float((unsigned)(w >> 32)); }
            const float mean = t1 * (1.0f / 1024.0f), var = fmaxf(t2 * (1.0f / 1024.0f) - mean * mean, 0.f);
            St[row] = (f32x2){mean, 1.0f / sqrtf(var + LN_EPS)}; }
        __syncthreads();
        f32x4 g0[2], g1[2], b0[2], b1[2];
#pragma unroll
        for (int bj = 0; bj < 2; ++bj) { const int c = EPI_C(s, bj); g0[bj] = *(const f32x4*)(lg + c); g1[bj] = *(const f32x4*)(lg + c + 4); b0[bj] = *(const f32x4*)(lb + c); b1[bj] = *(const f32x4*)(lb + c + 4); }
#pragma unroll
        for (int ai = 0; ai < 2; ++ai)
#pragma unroll
            for (int m = 0; m < 4; ++m) { const int rl = ai * 128 + wr * 64 + m * 16 + fr; const f32x2 sr = St[rl]; const float nb = -sr.x * sr.y;
#pragma unroll
                for (int bj = 0; bj < 2; ++bj) { float* op = out + (size_t)EPI_R(s) * 1024 + EPI_C(s, bj);
                    const f32x4 o0 = (acc[ai][bj][m][0] * sr.y + nb) * g0[bj] + b0[bj], o1 = (acc[ai][bj][m][1] * sr.y + nb) * g1[bj] + b1[bj];
                    *(f32x4*)op = o0; *(f32x4*)(op + 4) = o1; } }
        __syncthreads();
    }
};
}

__device__ __forceinline__ void tconv_tile(LAS float* t, const float* in, int ld_in, bf16_t* out, int ld_out, int k0, int n0) {
    const int tid = tid_local();
    { const int kr = tid >> 4, c4 = tid & 15;
#pragma unroll
      for (int ps = 0; ps < 2; ++ps) { const int k = kr + ps * 32; const f32x4 v = *(const f32x4*)(in + (size_t)(k0 + k) * ld_in + n0 + c4 * 4);
          t[k * 65 + c4 * 4 + 0] = v[0]; t[k * 65 + c4 * 4 + 1] = v[1]; t[k * 65 + c4 * 4 + 2] = v[2]; t[k * 65 + c4 * 4 + 3] = v[3]; } }
    __syncthreads();
    { const int nr = tid >> 3, k8 = tid & 7; f32x4 a, b;
#pragma unroll
      for (int e = 0; e < 4; ++e) { a[e] = t[(k8 * 8 + e) * 65 + nr]; b[e] = t[(k8 * 8 + 4 + e) * 65 + nr]; }
      *(u32x4*)(out + (size_t)(n0 + nr) * ld_out + k0 + k8 * 8) = pack8(a, b); }
    __syncthreads();
}

__device__ __forceinline__ void prep_a(LAS unsigned char* lds, const Params& P, int bid, int G) {
    unsigned char* ws = P.ws; const int tid = tid_local();
    bf16_t* WT1 = (bf16_t*)(ws + OFF_WT1); bf16_t* WINP = (bf16_t*)(ws + OFF_WINP); bf16_t* PWT = (bf16_t*)(ws + OFF_PWT); bf16_t* GLT = (bf16_t*)(ws + OFF_GLT);
    bf16_t* W5 = (bf16_t*)(ws + OFF_W5); bf16_t* W6 = (bf16_t*)(ws + OFF_W6); bf16_t* WT2 = (bf16_t*)(ws + OFF_WT2); bf16_t* BT3 = (bf16_t*)(ws + OFF_BT3);
    float* KTAB = (float*)(ws + OFF_KTAB); f32x2* AL = (f32x2*)(ws + OFF_AL);
    for (int task = bid; task < 256; task += G) {
        const int g = task >> 3, q = task & 7;
        LAS f32x2* PW = (LAS f32x2*)lds;
        LAS f32x2* Bb = PW + 33 * 64;
        LAS f32x2* Cc = Bb + 64 * 16;
        const float* a_re = P.in[5] + g * 64; const float* a_im = P.in[6] + g * 64; const float dt = expf(P.in[7][g]);
        for (int e = tid; e < 33 * 64; e += NTHR) { const int j = e >> 6, p = e & 63; const float lr = a_re[p], li = a_im[p];
            const float mag = expf(lr * dt * (float)j);
            double rev = (double)li * (double)dt * (double)j * 0.15915494309189535; rev -= floor(rev); const float rv = (float)rev;
            PW[e] = (f32x2){mag * __builtin_amdgcn_cosf(rv), mag * __builtin_amdgcn_sinf(rv)}; }
        __syncthreads();
        for (int e = tid; e < 1024; e += NTHR) { const int p = e >> 4, h = e & 15; const float lr = a_re[p], li = a_im[p]; const f32x2 ab = PW[64 + p];
            const float xr = ab.x - 1.0f, xi = ab.y, den = lr * lr + li * li;
            const float zr = (xr * lr + xi * li) / den, zi = (xi * lr - xr * li) / den;
            const float br = P.in[8][(size_t)(g * 64 + p) * 16 + h], bi = P.in[9][(size_t)(g * 64 + p) * 16 + h];
            Bb[e] = (f32x2){zr * br - zi * bi, zr * bi + zi * br};
            Cc[e] = (f32x2){P.in[10][(size_t)g * 1024 + e], P.in[11][(size_t)g * 1024 + e]}; }
        __syncthreads();
        for (int e = tid; e < 1024; e += NTHR) { const int j = 4 * q + (e >> 8), h = (e >> 4) & 15, h2 = e & 15; float a = 0.f;
            for (int p = 0; p < 64; ++p) { const f32x2 w = PW[j * 64 + p], bb = Bb[p * 16 + h2], cc = Cc[h * 64 + p];
                const float wr_ = w.x * bb.x - w.y * bb.y, wi_ = w.x * bb.y + w.y * bb.x; a += cc.x * wr_ - cc.y * wi_; }
            KTAB[((size_t)(g * 32 + j) * 16 + h) * 16 + h2] = a; }
        for (int v = tid; v < 2048; v += NTHR) { const int n = v >> 3, k0 = 64 * q + (v & 7) * 8, sx = k0 >> 4, h0 = k0 & 15; f32x4 a = {0.f, 0.f, 0.f, 0.f}, b = {0.f, 0.f, 0.f, 0.f};
            if (n < 128) { const int p = n & 63; const bool im = n >= 64; const f32x2 w = PW[(31 - sx) * 64 + p];
#pragma unroll
                for (int e = 0; e < 8; ++e) { const f32x2 bb = Bb[p * 16 + h0 + e]; const float val = im ? (w.x * bb.y + w.y * bb.x) : (w.x * bb.x - w.y * bb.y); if (e < 4) a[e] = val; else b[e - 4] = val; } }
            *(u32x4*)(WT2 + (size_t)(g * 256 + n) * 512 + k0) = pack8(a, b); }
        for (int v = tid; v < 1024; v += NTHR) { const int n = 64 * q + (v >> 4), t = n >> 4, h = n & 15, k0 = (v & 15) * 8; const bool im = k0 >= 64; const int p0 = k0 & 63; f32x4 a, b;
#pragma unroll
            for (int e = 0; e < 8; ++e) { const int p = p0 + e; const f32x2 w = PW[(t + 1) * 64 + p], cc = Cc[h * 64 + p];
                const float val = im ? -(cc.x * w.y + cc.y * w.x) : (cc.x * w.x - cc.y * w.y); if (e < 4) a[e] = val; else b[e - 4] = val; }
            *(u32x4*)(BT3 + (size_t)(g * 512 + n) * 640 + 512 + k0) = pack8(a, b); }
        if (q == 0 && tid < 64) AL[g * 64 + tid] = PW[32 * 64 + tid];
        __syncthreads();
    }
    LAS float* tt = (LAS float*)lds;
#define TC_JOB(x) \
        const float* in; int ld_in, ld_out, nT, xx; bf16_t* out; float wsc = 1.0f; int pcol = -1; \
        if ((x) < 1280)      { xx = (x);        in = P.in[2] + 1024; ld_in = 6144; out = WT1 + (size_t)1024 * 1024; ld_out = 1024; nT = 80; } \
        else if ((x) < 1344) { xx = (x) - 1280; in = P.in[13];       ld_in = 512;  out = GLT;       ld_out = 512;  nT = 8; } \
        else if ((x) < 1472) { xx = (x) - 1344; in = P.in[16];       ld_in = 1024; out = W5;        ld_out = 1536; nT = 16; } \
        else if ((x) < 1728) { xx = (x) - 1472; in = P.in[15];       ld_in = 1024; out = W5 + 512;  ld_out = 1536; nT = 16; } \
        else if ((x) < 1792) { xx = (x) - 1728; in = P.in[18];       ld_in = 1024; out = W6;        ld_out = 1280; nT = 16; } \
        else if ((x) < 2048) { xx = (x) - 1792; in = P.in[17];       ld_in = 1024; out = W6 + 256;  ld_out = 1280; nT = 16; } \
        else                 { xx = (x) - 2048; in = P.in[3];        ld_in = 256;  out = PWT;       ld_out = 1024; nT = 4; } \
        const int k0 = (xx / nT) * 64, n0 = (xx % nT) * 64; if ((x) < 1280 && n0 >= 2048) wsc = -1.4426950408889634f;     \
        if ((x) < 1280 && n0 >= 2048 && n0 < 4096) { const int j = (n0 - 2048) >> 6; pcol = 3072 + (j >> 2) * 128 + (j & 3) * 32; }     \
        (void)in; (void)ld_in; (void)out; (void)ld_out; (void)wsc; (void)pcol;
    for (int xb = bid; xb < 2112; xb += 5 * G) {
        f32x4 v[5][2];
        const int kr = tid >> 4, c4 = tid & 15;
#pragma unroll
        for (int j = 0; j < 5; ++j) { const int x = xb + j * G; if (x < 2112) { TC_JOB(x)
#pragma unroll
            for (int ps = 0; ps < 2; ++ps) { const float* src = (pcol < 0) ? in + (size_t)(k0 + kr + ps * 32) * ld_in + n0 + c4 * 4 : P.in[2] + (size_t)(k0 + kr + ps * 32) * 6144 + (c4 < 8 ? pcol + c4 * 4 : pcol + 1024 + (c4 - 8) * 4);
                v[j][ps] = *(const f32x4*)src; } } }
#pragma unroll
        for (int j = 0; j < 5; ++j) { const int x = xb + j * G; if (x < 2112) { LAS float* t = tt + j * (64 * 65);
#pragma unroll
            for (int ps = 0; ps < 2; ++ps) { const int k = kr + ps * 32; t[k * 65 + c4 * 4 + 0] = v[j][ps][0]; t[k * 65 + c4 * 4 + 1] = v[j][ps][1]; t[k * 65 + c4 * 4 + 2] = v[j][ps][2]; t[k * 65 + c4 * 4 + 3] = v[j][ps][3]; } } }
        __syncthreads();
        const int nr = tid >> 3, k8 = tid & 7;
#pragma unroll
        for (int j = 0; j < 5; ++j) { const int x = xb + j * G; if (x < 2112) { TC_JOB(x) const LAS float* t = tt + j * (64 * 65); f32x4 a, b;
#pragma unroll
            for (int e = 0; e < 4; ++e) { a[e] = t[(k8 * 8 + e) * 65 + nr] * wsc; b[e] = t[(k8 * 8 + 4 + e) * 65 + nr] * wsc; }
            *(u32x4*)(out + (size_t)(n0 + nr) * ld_out + k0 + k8 * 8) = pack8(a, b); } }
        __syncthreads();
    }
#undef TC_JOB
    for (int v = bid * NTHR + tid; v < 1024 * 128; v += G * NTHR) { const int d = v >> 7, i0 = (v & 127) * 8; const float* src = P.in[2] + (size_t)d * 6144 + i0;
        *(u32x4*)(WINP + (size_t)d * 1024 + i0) = pack8(*(const f32x4*)src, *(const f32x4*)(src + 4)); }
}

__device__ __forceinline__ void fold_prelude(LAS unsigned char* lds, const Params& P, int f) {
    unsigned char* ws = P.ws; const int tid = tid_local(); const int g = f >> 2, pn = f & 3;
    bf16_t* WINP = (bf16_t*)(ws + OFF_WINP); bf16_t* PWT = (bf16_t*)(ws + OFF_PWT);
    LAS float* tt = (LAS float*)lds;
    for (int x = 0; x < 16; ++x) tconv_tile(tt, P.in[3], 256, PWT, 1024, (4 * g + (x >> 2)) * 64, (x & 3) * 64);
    for (int v = tid; v < 8192; v += NTHR) { const int d = 256 * pn + (v >> 5), i0 = 256 * g + (v & 31) * 8; const float* src = P.in[2] + (size_t)d * 6144 + i0;
        *(u32x4*)(WINP + (size_t)d * 1024 + i0) = pack8(*(const f32x4*)src, *(const f32x4*)(src + 4)); }
    asm volatile("s_waitcnt vmcnt(0)" ::: "memory");
    __syncthreads();
}

__device__ __forceinline__ void prep_b_stream(const Params& P, int bi, int nb) {
    unsigned char* ws = P.ws; const size_t gt = (size_t)bi * NTHR + tid_local(), gn = (size_t)nb * NTHR;
    bf16_t* BT3 = (bf16_t*)(ws + OFF_BT3); const float* KTAB = (const float*)(ws + OFF_KTAB); bf16_t* XB = (bf16_t*)(ws + OFF_XB); bf16_t* A6 = (bf16_t*)(ws + OFF_A6);
    { const float* x = P.in[0]; const size_t N = (size_t)T * 128;
      for (size_t v = gt; v < N; v += 8 * gn) { f32x4 a[8], b[8];
#pragma unroll
          for (int u = 0; u < 8; ++u) { const size_t i = v + u * gn; if (i < N) { a[u] = __builtin_nontemporal_load((const f32x4*)(x + i * 8)); b[u] = __builtin_nontemporal_load((const f32x4*)(x + i * 8 + 4)); } }
#pragma unroll
          for (int u = 0; u < 8; ++u) { const size_t i = v + u * gn; if (i < N) *(u32x4*)(XB + i * 8) = pack8(a[u], b[u]); } } }
}

__device__ __forceinline__ void p_convert(const Params& P, int bi, int nb) {
    const size_t gt = (size_t)bi * NTHR + tid_local(), gn = (size_t)nb * NTHR; bf16_t* A6 = (bf16_t*)(P.ws + OFF_A6);
    { const float* p = P.in[1]; const size_t N = (size_t)T * 32;
      for (size_t v = gt; v < N; v += 8 * gn) { f32x4 a[8], b[8];
#pragma unroll
          for (int u = 0; u < 8; ++u) { const size_t i = v + u * gn; if (i < N) { a[u] = __builtin_nontemporal_load((const f32x4*)(p + i * 8)); b[u] = __builtin_nontemporal_load((const f32x4*)(p + i * 8 + 4)); } }
#pragma unroll
          for (int u = 0; u < 8; ++u) { const size_t i = v + u * gn; if (i < N) { const size_t r = i >> 5; const int c = (int)(i & 31) * 8; *(u32x4*)(A6 + r * 1280 + c) = pack8(a[u], b[u]); } } } }
}

__device__ __forceinline__ void bt3_expand(const Params& P, int bi, int nb) {
    unsigned char* ws = P.ws; const size_t gt = (size_t)bi * NTHR + tid_local(), gn = (size_t)nb * NTHR;
    bf16_t* BT3 = (bf16_t*)(ws + OFF_BT3); const float* KTAB = (const float*)(ws + OFF_KTAB);
    { const size_t N = (size_t)32 * 512 * 64;
      for (size_t v0 = gt; v0 < N; v0 += 8 * gn) { f32x4 a[8], b[8];
#pragma unroll
          for (int u = 0; u < 8; ++u) { const size_t v = v0 + u * gn; a[u] = (f32x4){0.f, 0.f, 0.f, 0.f}; b[u] = a[u];
              if (v < N) { const int kv = (int)(v & 63), n = (int)((v >> 6) & 511), g = (int)(v >> 15); const int t = n >> 4, h = n & 15, k0 = kv * 8, sx = k0 >> 4, h0 = k0 & 15;
                  if (sx <= t) { const float* src = KTAB + ((size_t)(g * 32 + (t - sx)) * 16 + h) * 16 + h0; a[u] = *(const f32x4*)src; b[u] = *(const f32x4*)(src + 4); } } }
#pragma unroll
          for (int u = 0; u < 8; ++u) { const size_t v = v0 + u * gn;
              if (v < N) { const int kv = (int)(v & 63), n = (int)((v >> 6) & 511), g = (int)(v >> 15); *(u32x4*)(BT3 + (size_t)(g * 512 + n) * 640 + kv * 8) = pack8(a[u], b[u]); } } } }
}

template <int W>
__device__ __forceinline__ void pool_run(const bf16_t* Z, bf16_t* YY, const float* scale, int t0, int c) {
    constexpr int NR = W + 7;
    const int pos0 = t0 & 2047;
    u32x4 rows[NR], gts[8];
#pragma unroll
    for (int j = 0; j < NR; ++j) { const int d = j - (W - 1); const bool ok = (pos0 + d) >= 0; const int tk = ok ? t0 + d : t0;
        u32x4 w = *(const u32x4*)(Z + (size_t)tk * 1024 + c); if (!ok) w = (u32x4){0u, 0u, 0u, 0u}; rows[j] = w; }
    bf16_t* yp = YY + (size_t)t0 * 1536 + 512 + c;
#pragma unroll
    for (int i = 0; i < 8; ++i) gts[i] = *(const u32x4*)(yp + (size_t)i * 1536);
    const f32x4 sc0 = *(const f32x4*)(scale + c), sc1 = *(const f32x4*)(scale + c + 4);
    f32x4 s0 = {0.f, 0.f, 0.f, 0.f}, s1 = {0.f, 0.f, 0.f, 0.f};
#pragma unroll
    for (int j = 0; j < W; ++j) { f32x4 a, b; unpack8(rows[j], a, b); s0 += a; s1 += b; }
#pragma unroll
    for (int i = 0; i < 8; ++i) {
        const int n = (pos0 + i + 1 < W) ? pos0 + i + 1 : W; const float inv = 1.0f / (float)n;
        f32x4 z0, z1, g0, g1; unpack8(rows[i + W - 1], z0, z1); unpack8(gts[i], g0, g1); g0 = g0 * sigm4(g0); g1 = g1 * sigm4(g1);
        *(u32x4*)(yp + (size_t)i * 1536) = pack8((s0 * inv - z0) * sc0 * g0, (s1 * inv - z1) * sc1 * g1);
        if (i < 7) { f32x4 a, b; unpack8(rows[i], a, b); s0 -= a; s1 -= b; unpack8(rows[i + W], a, b); s0 += a; s1 += b; }
    }
}
__device__ __forceinline__ void pool_pass(const Params& P, int wv, int nwv, int item0, int nitems) {
    const bf16_t* Z = (const bf16_t*)P.out; bf16_t* YY = (bf16_t*)(P.ws + OFF_YY); const float* scale = P.in[4];
    const int lane = tid_local() & 63;
    for (int it = wv; it < nitems; it += nwv) { const int item = item0 + it;
        const int gi = item / (T / 16), tr = item % (T / 16); const int t0 = (tr * 2 + (lane >> 5)) * 8, c = gi * 256 + (lane & 31) * 8;
        if (gi == 0) pool_run<2>(Z, YY, scale, t0, c); else if (gi == 1) pool_run<4>(Z, YY, scale, t0, c); else if (gi == 2) pool_run<8>(Z, YY, scale, t0, c); else pool_run<16>(Z, YY, scale, t0, c);
    }
}

__device__ __forceinline__ void ln_pass(const Params& P) {
    const f32x2* stats = (const f32x2*)(P.ws + OFF_STATS); float* out = P.out; const float* lg = P.in[19]; const float* lb = P.in[20];
    const int tl = tid_local(); const int lane = tl & 63, wv = blockIdx.x * (NTHR / 64) + (tl >> 6), nwv = gridDim.x * (NTHR / 64);
    f32x4 gg[4], bb[4];
#pragma unroll
    for (int i = 0; i < 4; ++i) { gg[i] = *(const f32x4*)(lg + i * 256 + lane * 4); bb[i] = *(const f32x4*)(lb + i * 256 + lane * 4); }
    for (int r0 = wv * 4; r0 < T; r0 += nwv * 4) {
        f32x4 h[4][4];
#pragma unroll
        for (int q = 0; q < 4; ++q)
#pragma unroll
            for (int i = 0; i < 4; ++i) h[q][i] = *(const f32x4*)(out + (size_t)(r0 + q) * 1024 + i * 256 + lane * 4);
        const f32x2 st = stats[(size_t)(r0 + (lane >> 4)) * 16 + (lane & 15)];
        float s1 = st.x, s2 = st.y;
#pragma unroll
        for (int o = 1; o < 16; o <<= 1) { s1 += __shfl_xor(s1, o); s2 += __shfl_xor(s2, o); }
#pragma unroll
        for (int q = 0; q < 4; ++q) {
            const float a1 = __shfl(s1, q * 16), a2 = __shfl(s2, q * 16);
            const float mu = a1 * (1.0f / 1024.0f); const float var = fmaxf(a2 * (1.0f / 1024.0f) - mu * mu, 0.f); const float rstd = 1.0f / sqrtf(var + LN_EPS);
#pragma unroll
            for (int i = 0; i < 4; ++i) { const f32x4 o = (h[q][i] - mu) * rstd * gg[i] + bb[i]; __builtin_nontemporal_store(o, (f32x4*)(out + (size_t)(r0 + q) * 1024 + i * 256 + lane * 4)); }
        }
    }
}

__global__ void __launch_bounds__(NTHR, 2) mega(Params P) {
    extern __shared__ __attribute__((aligned(16))) unsigned char lds_raw[];
    LAS unsigned char* lds = (LAS unsigned char*)lds_raw;
    unsigned char* ws = P.ws; const int G = gridDim.x, bid = blockIdx.x;
    bf16_t* XB = (bf16_t*)(ws + OFF_XB); bf16_t* GY = XB; bf16_t* YY = (bf16_t*)(ws + OFF_YY); bf16_t* A6 = (bf16_t*)(ws + OFF_A6); bf16_t* PG = (bf16_t*)(ws + OFF_PG);
    bf16_t* UA = (bf16_t*)(ws + OFF_UA); bf16_t* WT1 = (bf16_t*)(ws + OFF_WT1); bf16_t* WINP = (bf16_t*)(ws + OFF_WINP); bf16_t* PWT = (bf16_t*)(ws + OFF_PWT);
    bf16_t* GLT = (bf16_t*)(ws + OFF_GLT); bf16_t* W5 = (bf16_t*)(ws + OFF_W5); bf16_t* W6 = (bf16_t*)(ws + OFF_W6); bf16_t* WT2 = (bf16_t*)(ws + OFF_WT2); bf16_t* BT3 = (bf16_t*)(ws + OFF_BT3);
    bf16_t* Z = (bf16_t*)P.out; bf16_t* GS = Z + (size_t)T * 1024;
    if (threadIdx.x < 16) ((LAS unsigned*)(lds + LDS_STAGE))[threadIdx.x] = 0u;
    __syncthreads();
    const XcdBarrier gbar = xcd_barrier_post((unsigned*)(ws + OFF_CTL), (volatile LAS unsigned*)(lds + LDS_STAGE));
    if (ws == nullptr) cg::this_grid().sync();
#define GRID_BAR() xcd_barrier(gbar)
    const int xc = (G % 8 == 0) ? (bid % 8) * (G / 8) + bid / 8 : bid;

    if (G == 256) {
        if (bid < 88) prep_a(lds, P, bid, 88);
        else if (bid < 104) { fold_prelude(lds, P, bid - 88);
            pg8::Sched S{(const char*)PWT, (const char*)WINP, 512, 512, 1024, 1024, 1, 4, 4, 1, 0, 0, 4, 0, 0, 0, 16, bid - 88, 1};
            pg8::EpiFold E{WT1}; pg8::gemm_phase(lds, S, E); }
        else prep_b_stream(P, bid - 104, 152);
    } else {
        prep_a(lds, P, bid, G);
        GRID_BAR();
        { pg8::Sched S{(const char*)PWT, (const char*)WINP, 512, 512, 1024, 1024, 1, 4, 4, 1, 0, 0, 4, 0, 0, 0, G, bid, 1};
          pg8::EpiFold E{WT1}; pg8::gemm_phase(lds, S, E); }
        prep_b_stream(P, bid, G);
    }
    GRID_BAR();
    if (bid & 1) bt3_expand(P, bid >> 1, G >> 1);
    { pg8::Sched S{(const char*)XB, (const char*)WT1, 0, 0, 1024, 1024, 128, 24, 1, 1, 0, 0, 16, 0, 0, 0, G, bid, 0};
      pg8::EpiProj E{Z, YY, UA, A6, GS, PG}; pg8::gemm_phase(lds, S, E); }
    GRID_BAR();
    { pg8::Sched S{(const char*)UA, (const char*)WT2, (size_t)1024 * 640 * 2, (size_t)256 * 512 * 2, 640, 512, 4, 1, 32, 1, 0, 0, 8, 0, 0, 0, G, bid, 1};
      pg8::EpiState E{UA, (const f32x2*)(ws + OFF_AL)}; pg8::gemm_phase(lds, S, E);
      const int wv_in_blk = tid_local() >> 6; const int NIT = 4 * (T / 16);
      if (G == 256) { if (bid >= 128) pool_pass(P, (bid - 128) * 8 + wv_in_blk, 1024, 0, (NIT * 3) / 4); else pool_pass(P, bid * 8 + wv_in_blk, 1024, (NIT * 3) / 4, NIT / 4); }
      else pool_pass(P, bid * 8 + wv_in_blk, G * 8, 0, NIT); }
    GRID_BAR();
    { pg8::Sched S{(const char*)UA, (const char*)BT3, (size_t)1024 * 640 * 2, (size_t)512 * 640 * 2, 640, 640, 4, 2, 32, 1, 0, 0, 10, 0, 0, 0, G, xc, 1};
      pg8::EpiS5Out E{UA, P.in[12], GY}; pg8::gemm_phase(lds, S, E); }
    GRID_BAR();
    { pg8::Sched S{(const char*)GY, (const char*)GLT, 0, 0, 512, 512, 128, 2, 1, 1, 0, 0, 8, 0, 0, 0, G, bid, 0};
      pg8::EpiGlu E{GY, P.in[14], YY}; pg8::gemm_phase(lds, S, E); }
    GRID_BAR();
    if (bid & 1) p_convert(P, bid >> 1, G >> 1);
    { pg8::Sched S{(const char*)YY, (const char*)W5, 0, 0, 1536, 1536, 128, 4, 1, 2, 0, 0, 8, 512, 512, 16, G, bid, 0};
      pg8::EpiMerge E{GS, A6}; pg8::gemm_phase(lds, S, E); }
    GRID_BAR();
    { pg8::EpiOutLn E{PG, P.in[0], P.out, P.in[19], P.in[20], (unsigned long long*)(ws + OFF_STATS), (unsigned*)(ws + OFF_CTL + 16384), (unsigned*)(ws + OFF_CTL) + XB_TMO};
#pragma unroll 1
      for (int rnd = 0; rnd < 2; ++rnd) {
          pg8::Sched S{(const char*)A6, (const char*)W6, 0, 0, 1280, 1280, 128, 4, 1, 2, 0, 0, 4, 256, 256, 16, G, bid, 0}; S.ui0 = rnd; S.nui = 1;
          pg8::gemm_phase(lds, S, E);
      } }
}

extern "C" void kernel_launch(void* const* d_in, const int* in_sizes, int n_in, void* d_out, int out_size, void* d_ws, size_t ws_size, hipStream_t stream) {
    static int grid = 0;
    if (grid == 0) {
        if (n_in != 21 || out_size != T * 1024 || ws_size < WS_END) { fprintf(stderr, "kernel_launch: unexpected shapes: n_in %d out %d ws %zu (need %zu)\n", n_in, out_size, ws_size, (size_t)WS_END); grid = -1; return; }
        int dev = 0, cus = 0, per_cu = 0;
        (void)hipGetDevice(&dev); (void)hipDeviceGetAttribute(&cus, hipDeviceAttributeMultiprocessorCount, dev);
        if (hipFuncSetAttribute((const void*)mega, hipFuncAttributeMaxDynamicSharedMemorySize, LDS_BYTES) != hipSuccess) { fprintf(stderr, "kernel_launch: hipFuncSetAttribute failed\n"); grid = -1; return; }
        if (hipOccupancyMaxActiveBlocksPerMultiprocessor(&per_cu, (const void*)mega, NTHR, LDS_BYTES) != hipSuccess || per_cu < 1) { fprintf(stderr, "kernel_launch: occupancy query says %d\n", per_cu); per_cu = 1; }
        (void)hipGetLastError();
        grid = cus;
        if (grid != 256) { fprintf(stderr, "kernel_launch: this build needs a 256-CU device (got %d)\n", cus); grid = -1; return; }
    }
    if (grid < 0) return;
    if (hipMemsetAsync((char*)d_ws + OFF_CTL, 0, SZ_CTL, stream) != hipSuccess) { fprintf(stderr, "kernel_launch: memset failed\n"); return; }
    Params p{};
    for (int i = 0; i < 21; ++i) p.in[i] = (const float*)d_in[i];
    p.out = (float*)d_out; p.ws = (unsigned char*)d_ws;
    void* args[] = {&p};
    hipError_t e = hipLaunchCooperativeKernel((const void*)mega, dim3(grid), dim3(NTHR), args, LDS_BYTES, stream);
    if (e != hipSuccess) fprintf(stderr, "cooperative launch failed: %s (grid %d)\n", hipGetErrorString(e), grid);
}
```

```cpp
#include <hip/hip_runtime.h>
#include <hip/hip_cooperative_groups.h>
#include <cstdio>
namespace cg = cooperative_groups;

#define LAS __attribute__((address_space(3)))
typedef unsigned short bf16_t;
typedef short bf16x8 __attribute__((ext_vector_type(8)));
typedef float f32x4 __attribute__((ext_vector_type(4)));
typedef float f32x2 __attribute__((ext_vector_type(2)));
typedef unsigned u32x4 __attribute__((ext_vector_type(4)));

constexpr int T = 32768;
constexpr int NTHR = 512;
constexpr int LDS_STAGE = 131072;
constexpr int LDS_BYTES = LDS_STAGE + 64;
constexpr float ALPHA = 1.189207115002721f;
constexpr float LN_EPS = 1e-5f;

constexpr size_t SZ_XB = (size_t)T * 1024 * 2;
constexpr size_t SZ_YY = (size_t)T * 1536 * 2;
constexpr size_t SZ_A6 = (size_t)T * 1280 * 2;
constexpr size_t SZ_PG = (size_t)T * 1024 * 2;
constexpr size_t SZ_UA = (size_t)32 * 1024 * 640 * 2;
constexpr size_t SZ_WT1 = (size_t)6144 * 1024 * 2;
constexpr size_t SZ_WINP = (size_t)1024 * 1024 * 2;
constexpr size_t SZ_PWT = (size_t)256 * 1024 * 2;
constexpr size_t SZ_GLT = (size_t)512 * 512 * 2;
constexpr size_t SZ_W5 = (size_t)1024 * 1536 * 2;
constexpr size_t SZ_W6 = (size_t)1024 * 1280 * 2;
constexpr size_t SZ_WT2 = (size_t)32 * 256 * 512 * 2;
constexpr size_t SZ_BT3 = (size_t)32 * 512 * 640 * 2;
constexpr size_t SZ_KTAB = (size_t)32 * 32 * 256 * 4;
constexpr size_t SZ_AL = (size_t)32 * 64 * 8;
constexpr size_t SZ_STATS = (size_t)T * 16 * 8;
constexpr size_t OFF_XB = 0;
constexpr size_t OFF_YY = OFF_XB + SZ_XB;
constexpr size_t OFF_A6 = OFF_YY + SZ_YY;
constexpr size_t OFF_PG = OFF_A6 + SZ_A6;
constexpr size_t OFF_UA = OFF_PG + SZ_PG;
constexpr size_t OFF_WT1 = OFF_UA + SZ_UA;
constexpr size_t OFF_WINP = OFF_WT1 + SZ_WT1;
constexpr size_t OFF_PWT = OFF_WINP + SZ_WINP;
constexpr size_t OFF_GLT = OFF_PWT + SZ_PWT;
constexpr size_t OFF_W5 = OFF_GLT + SZ_GLT;
constexpr size_t OFF_W6 = OFF_W5 + SZ_W5;
constexpr size_t OFF_WT2 = OFF_W6 + SZ_W6;
constexpr size_t OFF_BT3 = OFF_WT2 + SZ_WT2;
constexpr size_t OFF_KTAB = OFF_BT3 + SZ_BT3;
constexpr size_t OFF_AL = OFF_KTAB + SZ_KTAB;
constexpr size_t OFF_STATS = OFF_AL + SZ_AL;
constexpr size_t OFF_CTL = OFF_STATS + SZ_STATS;
constexpr size_t SZ_CTL = 65536;
constexpr size_t WS_END = OFF_CTL + SZ_CTL;

struct Params { const float* in[21]; float* out; unsigned char* ws; };

__device__ __forceinline__ int tid_local() { int t = threadIdx.x; asm volatile("" : "+v"(t)); return t; }
typedef __bf16 bf16x2_t __attribute__((ext_vector_type(2)));
__device__ __forceinline__ unsigned cvt_pk_bf16(float lo, float hi) { const f32x2 v = {lo, hi}; return __builtin_bit_cast(unsigned, __builtin_convertvector(v, bf16x2_t)); }
__device__ __forceinline__ u32x4 pack8(f32x4 a, f32x4 b) { u32x4 w; w.x = cvt_pk_bf16(a[0], a[1]); w.y = cvt_pk_bf16(a[2], a[3]); w.z = cvt_pk_bf16(b[0], b[1]); w.w = cvt_pk_bf16(b[2], b[3]); return w; }
__device__ __forceinline__ void unpack8(u32x4 w, f32x4& a, f32x4& b) {
    a[0] = __uint_as_float(w.x << 16); a[1] = __uint_as_float(w.x & 0xffff0000u); a[2] = __uint_as_float(w.y << 16); a[3] = __uint_as_float(w.y & 0xffff0000u);
    b[0] = __uint_as_float(w.z << 16); b[1] = __uint_as_float(w.z & 0xffff0000u); b[2] = __uint_as_float(w.w << 16); b[3] = __uint_as_float(w.w & 0xffff0000u); }
__device__ __forceinline__ float sigm(float x) { return __builtin_amdgcn_rcpf(1.0f + __expf(-x)); }
__device__ __forceinline__ f32x4 sigm4(f32x4 v) { f32x4 r; r[0] = sigm(v[0]); r[1] = sigm(v[1]); r[2] = sigm(v[2]); r[3] = sigm(v[3]); return r; }
__device__ __forceinline__ f32x4 gelu4(f32x4 v) {
    const f32x4 u = v * ((v * v) * (-0.10294324f) + (-2.3022082f)); f32x4 r;
#pragma unroll
    for (int e = 0; e < 4; ++e) r[e] = v[e] * __builtin_amdgcn_rcpf(1.0f + __builtin_amdgcn_exp2f(u[e]));
    return r; }


#define XB_TMO      128
#define XB_XCNT(j)  (256  + 64 * (j))
#define XB_XSUB(j)  (1280 + 64 * (j))
#define XB_XGEN(j)  (2304 + 64 * (j))
#define XB_TOP      3328
#define XB_TOPGEN   3392
#define XCD_BAR_WORDS 3456
#define XB_SPIN_CAP (1u << 22)
__device__ __forceinline__ unsigned xb_ld(unsigned* p)              { return __hip_atomic_load(p, __ATOMIC_RELAXED, __HIP_MEMORY_SCOPE_AGENT); }
__device__ __forceinline__ unsigned xb_add(unsigned* p, unsigned v) { return __hip_atomic_fetch_add(p, v, __ATOMIC_RELAXED, __HIP_MEMORY_SCOPE_AGENT); }
__device__ __forceinline__ unsigned xb_xcc_id() { return (unsigned)__builtin_amdgcn_s_getreg((3 << 11) | 20) & 0xFu; }
#define XB_SPIN(cond, bar) do { unsigned _sp = 0; while (cond) { __builtin_amdgcn_s_sleep(1); \
    if ((++_sp & 255u) == 0u) { if (xb_ld(&(bar)[XB_TMO])) break; if (_sp > XB_SPIN_CAP) { atomicAdd(&(bar)[XB_TMO], 1u); break; } } } } while (0)
struct XcdBarrier { unsigned* bar; unsigned x; volatile LAS unsigned* st; };
__device__ __forceinline__ XcdBarrier xcd_barrier_post(unsigned* bar, volatile LAS unsigned* st) {
    XcdBarrier b; b.bar = bar; b.x = xb_xcc_id(); b.st = st;
    if (threadIdx.x == 0) (void)xb_add(&bar[XB_XCNT(b.x)], 1u);
    return b;
}
__device__ __forceinline__ void xcd_barrier_complete(unsigned* bar, unsigned x, unsigned& nloc, unsigned& nx) {
    const unsigned G = gridDim.x * gridDim.y * gridDim.z;
    unsigned sum, cnt, mine, sp = 0u;
    for (;;) {
        sum = 0u; cnt = 0u; mine = 0u;
#pragma unroll
        for (unsigned j = 0; j < 16; ++j) { const unsigned c = xb_ld(&bar[XB_XCNT(j)]); sum += c; cnt += (c > 0u) ? 1u : 0u; mine = (j == x) ? c : mine; }
        if (sum == G) break;
        __builtin_amdgcn_s_sleep(1);
        if ((++sp & 255u) == 0u) { if (xb_ld(&bar[XB_TMO])) break; if (sp > XB_SPIN_CAP) { atomicAdd(&bar[XB_TMO], 1u); break; } }
    }
    nloc = mine > 0u ? mine : 1u; nx = cnt > 0u ? cnt : 1u;
}
__device__ __forceinline__ void xcd_barrier(const XcdBarrier& b) {
    asm volatile("s_waitcnt vmcnt(0)" ::: "memory");
    __syncthreads();
    if (threadIdx.x == 0) {
        unsigned* bar = b.bar;
        __builtin_amdgcn_s_waitcnt(0);
        unsigned nloc = b.st[0], nx = b.st[1];
        if (nloc == 0u) { xcd_barrier_complete(bar, b.x, nloc, nx); b.st[0] = nloc; b.st[1] = nx; }
        const unsigned old = xb_add(&bar[XB_XSUB(b.x)], 1u);
        const unsigned gen = old / nloc;
        if (old + 1u == (gen + 1u) * nloc) {
            __builtin_amdgcn_fence(__ATOMIC_RELEASE, "agent");
            asm volatile("s_waitcnt vmcnt(0)" ::: "memory");
            const unsigned og = xb_add(&bar[XB_TOP], 1u);
            const unsigned tg = og / nx;
            if (og + 1u == (tg + 1u) * nx) xb_add(&bar[XB_TOPGEN], 1u);
            else XB_SPIN(xb_ld(&bar[XB_TOPGEN]) == tg, bar);
            __builtin_amdgcn_fence(__ATOMIC_ACQUIRE, "agent");
            xb_add(&bar[XB_XGEN(b.x)], 1u);
            asm volatile("s_waitcnt vmcnt(0)" ::: "memory");
        } else {
            XB_SPIN(xb_ld(&bar[XB_XGEN(b.x)]) == gen, bar);
            __builtin_amdgcn_fence(__ATOMIC_ACQUIRE, "agent");
            asm volatile("s_waitcnt vmcnt(0)" ::: "memory");
        }
    }
    __syncthreads();
}

namespace pg8 {
constexpr int BM = 256, BK = 64, HALF = 128, HTB = HALF * BK * 2, NXCD = 8, WGM = 8;
__device__ __forceinline__ int lds_byte(int r, int c) { const int st = (r >> 4) * 2 + (c >> 5), rr = r & 15, cc = c & 31, ob = rr * 64 + cc * 2; return st * 1024 + (ob ^ (((ob >> 9) & 1) << 5)); }
__device__ __forceinline__ void stage_rc(int b, int& R, int& C) { const int st = b / 1024, sb = b % 1024, swz = sb ^ (((sb >> 9) & 1) << 5); R = (st >> 1) * 16 + swz / 64; C = (st & 1) * 32 + (swz % 64) / 2; }
__device__ __forceinline__ int perm32(int rho) { const int n = rho >> 4, i = rho & 15; return 8 * (i >> 2) + 4 * n + (i & 3); }

struct Seg { const char* A; const char* B; int nt, fin, pm, pn, g; };

struct Sched {
    const char* A; const char* B; size_t gsA, gsB;
    int lda, ldb;
    int nM, nN, nG;
    int nseg, ka0, kb0, nt0, ka1, kb1, nt1;
    int G, c, mode;
    int ui0 = 0, nui = 1 << 30;
    __device__ __forceinline__ bool next(int i, Seg& s) const {
        const int ur = (nseg == 2) ? (i >> 1) : i, si = (nseg == 2) ? (i & 1) : 0; if (ur >= nui) return false; const int ui = ui0 + ur;
        const int nwg = nM * nN * nG; const long L = (long)ui * G + c; if (L >= nwg) return false;
        int g = 0, pm, pn;
        if (mode == 0) {
            int wgid = (int)L; { const int q = nwg / NXCD, r = nwg % NXCD, xcd = wgid % NXCD, off = wgid / NXCD; wgid = (xcd < r ? xcd * (q + 1) : r * (q + 1) + (xcd - r) * q) + off; }
            const int nig = WGM * nN, gid = wgid / nig, fm = gid * WGM, gsz = (nM - fm) < WGM ? (nM - fm) : WGM;
            pm = fm + ((wgid % nig) % gsz); pn = (wgid % nig) / gsz;
        } else { const int per = nM * nN; g = (int)L / per; const int rem = (int)L % per; pm = rem / nN; pn = rem % nN; }
        const int ka = si ? ka1 : ka0, kb = si ? kb1 : kb0;
        s.A = A + (size_t)g * gsA + ((size_t)pm * BM * lda + ka) * 2; s.B = B + (size_t)g * gsB + ((size_t)pn * BM * ldb + kb) * 2;
        s.nt = si ? nt1 : nt0; s.fin = (si == nseg - 1) ? 1 : 0; s.pm = pm; s.pn = pn; s.g = g; return true;
    }
};

typedef f32x4 Acc[2][2][4][2];
#define EPI_ROWS(s) _Pragma("unroll") for (int ai = 0; ai < 2; ++ai) _Pragma("unroll") for (int m = 0; m < 4; ++m)
#define EPI_FENCE() do { if (m == 3) asm volatile("" ::: "memory"); } while (0)
#define EPI_R(s) ((s).pm * 256 + ai * 128 + wr * 64 + m * 16 + fr)
#define EPI_C(s, bj) ((s).pn * 256 + wc * 64 + (bj) * 32 + fq * 8)

template <class Epi>
__device__ __forceinline__ void gemm_phase(LAS unsigned char* lds, const Sched& S, const Epi& E) {
    const int tid = tid_local(), wid = __builtin_amdgcn_readfirstlane(tid >> 6), lane = tid & 63, wr = wid >> 2, wc = wid & 3, fr = lane & 15, fq = lane >> 4;
    const int lda = S.lda, ldb = S.ldb;
    unsigned voffA[2], voffB[2];
#pragma unroll
    for (int i = 0; i < 2; ++i) { int R, C; stage_rc(tid * 16 + i * 8192, R, C); const int Rb = (R >> 5) * 64 + perm32(R & 31);
        voffA[i] = (unsigned)(R * lda + C) * 2u; voffB[i] = (unsigned)(Rb * ldb + C) * 2u; }
    const size_t kstep = (size_t)(BK * 2);
    const size_t hstepA = (size_t)HALF * lda * 2, hstepB = (size_t)32 * ldb * 2;
    const unsigned ldsw = (unsigned)wid * 1024u;
    const int aoff = lds_byte(wr * 64 + fr, fq * 8), boff = lds_byte(wc * 32 + fr, fq * 8);
#define PG8_SA(b, h) (((b) * 2 + (h)) * HTB)
#define PG8_SB(b, h) ((4 + (b) * 2 + (h)) * HTB)
#define PG8_STAGE(bufoff, gbase, voff) do { _Pragma("unroll") for (int _i = 0; _i < 2; ++_i) \
        __builtin_amdgcn_global_load_lds((const unsigned*)((const char*)(gbase) + (voff)[_i]), (LAS unsigned*)(lds + (bufoff) + ldsw + _i * 8192), 16, 0, 0); } while (0)
#define PG8_LDA(dst, b, h) do { _Pragma("unroll") for (int m = 0; m < 4; ++m) _Pragma("unroll") for (int k = 0; k < 2; ++k) dst[m][k] = *(const LAS bf16x8*)(lds + PG8_SA(b, h) + aoff + m * 2048 + k * 1024); } while (0)
#define PG8_LDB(dst, b, h) do { _Pragma("unroll") for (int n = 0; n < 2; ++n) _Pragma("unroll") for (int k = 0; k < 2; ++k) dst[n][k] = *(const LAS bf16x8*)(lds + PG8_SB(b, h) + boff + n * 2048 + k * 1024); } while (0)
#define PG8_MMA(ai, bj, At, Bt) do { __builtin_amdgcn_s_setprio(1); _Pragma("unroll") for (int m = 0; m < 4; ++m) _Pragma("unroll") for (int n = 0; n < 2; ++n) _Pragma("unroll") for (int k = 0; k < 2; ++k) \
        acc[ai][bj][m][n] = __builtin_amdgcn_mfma_f32_16x16x32_bf16(Bt[n][k], At[m][k], acc[ai][bj][m][n], 0, 0, 0); __builtin_amdgcn_s_setprio(0); } while (0)
#define PG8_WAIT_V(n) asm volatile("s_waitcnt vmcnt(" #n ")" ::: "memory")
#define PG8_WAIT_L(n) asm volatile("s_waitcnt lgkmcnt(" #n ")" ::: "memory")
#define PG8_BAR __builtin_amdgcn_s_barrier()
#define PG8_SCHED __builtin_amdgcn_sched_barrier(0)
#define PG8_ZERO() do { _Pragma("unroll") for (int a = 0; a < 2; ++a) _Pragma("unroll") for (int b = 0; b < 2; ++b) _Pragma("unroll") for (int m = 0; m < 4; ++m) _Pragma("unroll") for (int n = 0; n < 2; ++n) acc[a][b][m][n] = (f32x4){0.f, 0.f, 0.f, 0.f}; } while (0)
    Seg cur, nxt; int ui = 0;
    if (!S.next(0, cur)) return;
    Acc acc;
    PG8_ZERO();
    bf16x8 At[4][2], B0[2][2], B1[2][2];
    const char* cA = cur.A; const char* cB = cur.B; int nt = cur.nt;
    PG8_STAGE(PG8_SB(0, 0), cB, voffB); PG8_STAGE(PG8_SA(0, 0), cA, voffA); PG8_STAGE(PG8_SB(0, 1), cB + hstepB, voffB); PG8_STAGE(PG8_SA(0, 1), cA + hstepA, voffA);
    if (wr == 1) PG8_BAR;
    PG8_WAIT_V(4); PG8_BAR;
    PG8_STAGE(PG8_SB(1, 0), cB + kstep, voffB); PG8_STAGE(PG8_SA(1, 0), cA + kstep, voffA); PG8_STAGE(PG8_SB(1, 1), cB + hstepB + kstep, voffB);
    PG8_WAIT_V(6); PG8_BAR;
    for (;;) {
        const bool has_next = S.next(ui + 1, nxt);
        const char* nA = has_next ? nxt.A : cA; const char* nB = has_next ? nxt.B : cB;
        for (int t = 0; t < nt; t += 2) {
            const bool last = (t == nt - 2);
            const char* a1 = cA + (size_t)(t + 1) * kstep;
            const char* a2 = last ? nA : cA + (size_t)(t + 2) * kstep; const char* b2 = last ? nB : cB + (size_t)(t + 2) * kstep;
            const char* a3 = a2 + kstep; const char* b3 = b2 + kstep;
            PG8_LDB(B0, 0, 0); PG8_SCHED; PG8_LDA(At, 0, 0); PG8_STAGE(PG8_SA(1, 1), a1 + hstepA, voffA);
            PG8_WAIT_L(8); PG8_BAR; PG8_WAIT_L(0); PG8_MMA(0, 0, At, B0); PG8_BAR; PG8_SCHED;
            PG8_LDB(B1, 0, 1); PG8_STAGE(PG8_SB(0, 0), b2, voffB);
            PG8_BAR; PG8_WAIT_L(0); PG8_MMA(0, 1, At, B1); PG8_BAR;
            PG8_LDA(At, 0, 1); PG8_STAGE(PG8_SA(0, 0), a2, voffA);
            PG8_BAR; PG8_WAIT_L(0); PG8_MMA(1, 0, At, B0); PG8_BAR; PG8_SCHED;
            PG8_STAGE(PG8_SB(0, 1), b2 + hstepB, voffB);
            PG8_WAIT_V(6); PG8_BAR; PG8_MMA(1, 1, At, B1); PG8_BAR;
            PG8_LDB(B0, 1, 0); PG8_SCHED; PG8_LDA(At, 1, 0); PG8_STAGE(PG8_SA(0, 1), a2 + hstepA, voffA);
            PG8_WAIT_L(8); PG8_BAR; PG8_WAIT_L(0); PG8_MMA(0, 0, At, B0); PG8_BAR; PG8_SCHED;
            PG8_LDB(B1, 1, 1); PG8_STAGE(PG8_SB(1, 0), b3, voffB);
            PG8_BAR; PG8_WAIT_L(0); PG8_MMA(0, 1, At, B1); PG8_BAR;
            PG8_LDA(At, 1, 1); PG8_STAGE(PG8_SA(1, 0), a3, voffA);
            PG8_BAR; PG8_WAIT_L(0); PG8_MMA(1, 0, At, B0); PG8_BAR; PG8_SCHED;
            PG8_STAGE(PG8_SB(1, 1), b3 + hstepB, voffB);
            PG8_WAIT_V(6); PG8_BAR; PG8_MMA(1, 1, At, B1); PG8_BAR;
        }
        if (cur.fin) { if constexpr (!Epi::AFTER_DRAIN) E.fin(acc, cur, wr, wc, fr, fq); }
        else E.mid(acc, cur, wr, wc, fr, fq);
        if (!has_next) break;
        if (cur.fin) PG8_ZERO();
        cur = nxt; cA = nA; cB = nB; nt = cur.nt; ++ui;
    }
    PG8_WAIT_V(0);
    if (wr == 0) PG8_BAR;
    PG8_BAR;
    if constexpr (Epi::AFTER_DRAIN) E.fused(acc, cur, wr, wc, fr, fq, lds);
#undef PG8_SA
#undef PG8_SB
#undef PG8_STAGE
#undef PG8_LDA
#undef PG8_LDB
#undef PG8_MMA
#undef PG8_WAIT_V
#undef PG8_WAIT_L
#undef PG8_BAR
#undef PG8_SCHED
#undef PG8_ZERO
}

struct EpiFold {
    static constexpr bool AFTER_DRAIN = false;
    bf16_t* WT1;
    __device__ __forceinline__ void mid(Acc&, const Seg&, int, int, int, int) const {}
    __device__ __forceinline__ void fin(Acc& acc, const Seg& s, int wr, int wc, int fr, int fq) const {
        EPI_ROWS(s) { const int r = EPI_R(s);
#pragma unroll
            for (int bj = 0; bj < 2; ++bj) { const int c = EPI_C(s, bj); *(u32x4*)(WT1 + (size_t)(s.g * 256 + r) * 1024 + c) = pack8(acc[ai][bj][m][0], acc[ai][bj][m][1]); } }
    }
};
struct EpiProj {
    static constexpr bool AFTER_DRAIN = false;
    bf16_t *Z, *YY, *UA, *A6, *GS, *PG;
    __device__ __forceinline__ void mid(Acc&, const Seg&, int, int, int, int) const {}
    __device__ __forceinline__ void fin(Acc& acc, const Seg& s, int wr, int wc, int fr, int fq) const {
        const int pn = s.pn;
        if (pn == 8 || pn == 9) {
            EPI_ROWS(s) { const int r = EPI_R(s);
#pragma unroll
                for (int bj = 0; bj < 2; ++bj) { const int c = (pn - 8) * 256 + wc * 64 + bj * 32 + fq * 8; const int g = c >> 4, h0 = c & 15;
                    __builtin_nontemporal_store(pack8(acc[ai][bj][m][0], acc[ai][bj][m][1]), (u32x4*)(UA + (size_t)g * (1024 * 640) + (size_t)(r >> 5) * 640 + (r & 31) * 16 + h0)); } }
            return;
        }
        if (pn >= 12 && pn < 20) {
            const int cp = (pn - 12) * 128 + wc * 32 + fq * 8;
            EPI_ROWS(s) { const int r = EPI_R(s); f32x4 p0 = acc[ai][0][m][0], p1 = acc[ai][0][m][1], q0 = acc[ai][1][m][0], q1 = acc[ai][1][m][1];
#pragma unroll
                for (int e = 0; e < 4; ++e) { p0[e] = 1.0f + __builtin_amdgcn_exp2f(p0[e]); p1[e] = 1.0f + __builtin_amdgcn_exp2f(p1[e]);
                    q0[e] = p0[e] * __builtin_amdgcn_rcpf(1.0f + __builtin_amdgcn_exp2f(q0[e])); q1[e] = p1[e] * __builtin_amdgcn_rcpf(1.0f + __builtin_amdgcn_exp2f(q1[e])); }
                __builtin_nontemporal_store(pack8(p0, p1), (u32x4*)(A6 + (size_t)r * 1280 + 256 + cp)); __builtin_nontemporal_store(pack8(q0, q1), (u32x4*)(GS + (size_t)r * 1024 + cp)); }
            return;
        }
        bf16_t* base; int ld, c0, act;
        if (pn < 4) { base = Z; ld = 1024; c0 = pn * 256; act = 0; }
        else if (pn < 8) { base = YY + 512; ld = 1536; c0 = (pn - 4) * 256; act = 0; }
        else if (pn < 12) { base = YY; ld = 1536; c0 = (pn - 10) * 256; act = 0; }
        else { base = PG; ld = 1024; c0 = (pn - 20) * 256; act = 2; }
        const unsigned off0 = __umul24((unsigned)(s.pm * 256 + wr * 64 + fr), (unsigned)ld) + (unsigned)(c0 + wc * 64 + fq * 8);
        if (act == 0) {
            EPI_ROWS(s) { const unsigned offr = off0 + (unsigned)((ai * 128 + m * 16) * ld);
#pragma unroll
                for (int bj = 0; bj < 2; ++bj) __builtin_nontemporal_store(pack8(acc[ai][bj][m][0], acc[ai][bj][m][1]), (u32x4*)(base + (offr + bj * 32)));
                }
        } else {
            EPI_ROWS(s) { const unsigned offr = off0 + (unsigned)((ai * 128 + m * 16) * ld);
#pragma unroll
                for (int bj = 0; bj < 2; ++bj) { f32x4 v0, v1;
#pragma unroll
                    for (int e = 0; e < 4; ++e) { v0[e] = __builtin_amdgcn_rcpf(1.0f + __builtin_amdgcn_exp2f(acc[ai][bj][m][0][e])); v1[e] = __builtin_amdgcn_rcpf(1.0f + __builtin_amdgcn_exp2f(acc[ai][bj][m][1][e])); }
                    __builtin_nontemporal_store(pack8(v0, v1), (u32x4*)(base + (offr + bj * 32))); }
                }
        }
    }
};
struct EpiState {
    static constexpr bool AFTER_DRAIN = true;
    bf16_t* UA; const f32x2* AL;
    __device__ __forceinline__ void mid(Acc&, const Seg&, int, int, int, int) const {}
    __device__ __forceinline__ void fin(Acc&, const Seg&, int, int, int, int) const {}
    __device__ __forceinline__ void fused(Acc& acc, const Seg& s, int wr, int wc, int fr, int fq, LAS unsigned char* lds) const {
        LAS float* Sl = (LAS float*)lds;
        if (wc < 2) {
            EPI_ROWS(s) { const int rl = ai * 128 + wr * 64 + m * 16 + fr;
#pragma unroll
                for (int bj = 0; bj < 2; ++bj) { const int c = wc * 64 + bj * 32 + fq * 8; *(LAS f32x4*)(Sl + rl * 128 + c) = acc[ai][bj][m][0]; *(LAS f32x4*)(Sl + rl * 128 + c + 4) = acc[ai][bj][m][1]; } } }
        __syncthreads();
        const int tid = tid_local(), bl = tid >> 6, p = tid & 63;
        if (bl < 4) {
            const f32x2 al = AL[s.g * 64 + p];
            float er = 0.f, ei = 0.f;
            bf16_t* dst = UA + (size_t)s.g * (1024 * 640) + (size_t)(s.pm * 256 + bl * 64) * 640 + 512 + p;
            for (int c = 0; c < 64; ++c) {
                const float sr = Sl[(bl * 64 + c) * 128 + p], si = Sl[(bl * 64 + c) * 128 + 64 + p];
                const unsigned w = cvt_pk_bf16(er, ei);
                dst[(size_t)c * 640] = (bf16_t)(w & 0xffffu); dst[(size_t)c * 640 + 64] = (bf16_t)(w >> 16);
                const float nr = al.x * er - al.y * ei + sr, ni = al.x * ei + al.y * er + si; er = nr; ei = ni;
            }
        }
        __syncthreads();
    }
};
struct EpiS5Out {
    static constexpr bool AFTER_DRAIN = false;
    const bf16_t* __restrict__ UA; const float* __restrict__ dskip; bf16_t* __restrict__ GY;
    __device__ __forceinline__ void mid(Acc&, const Seg&, int, int, int, int) const {}
    __device__ __forceinline__ void fin(Acc& acc, const Seg& s, int wr, int wc, int fr, int fq) const {
        f32x4 d0[2], d1[2];
#pragma unroll
        for (int bj = 0; bj < 2; ++bj) { const int h0 = EPI_C(s, bj) & 15; d0[bj] = *(const f32x4*)(dskip + s.g * 16 + h0); d1[bj] = *(const f32x4*)(dskip + s.g * 16 + h0 + 4); }
#pragma unroll
        for (int ai = 0; ai < 2; ++ai) {
            u32x4 uw[4][2];
#pragma unroll
            for (int m = 0; m < 4; ++m)
#pragma unroll
                for (int bj = 0; bj < 2; ++bj) uw[m][bj] = *(const u32x4*)(UA + (size_t)s.g * (1024 * 640) + (size_t)EPI_R(s) * 640 + EPI_C(s, bj));
#pragma unroll
            for (int m = 0; m < 4; ++m) { const int R = EPI_R(s);
#pragma unroll
                for (int bj = 0; bj < 2; ++bj) { const int c = EPI_C(s, bj); const int t = c >> 4, h0 = c & 15; f32x4 u0, u1; unpack8(uw[m][bj], u0, u1);
                    const f32x4 v0 = gelu4(acc[ai][bj][m][0] + d0[bj] * u0), v1 = gelu4(acc[ai][bj][m][1] + d1[bj] * u1);
                    *(u32x4*)(GY + (size_t)(R * 32 + t) * 512 + s.g * 16 + h0) = pack8(v0, v1); } }
            asm volatile("" ::: "memory");
        }
    }
};
struct EpiGlu {
    static constexpr bool AFTER_DRAIN = false;
    const bf16_t* __restrict__ GY; const float* __restrict__ bias; bf16_t* YY;
    __device__ __forceinline__ void mid(Acc&, const Seg&, int, int, int, int) const {}
    __device__ __forceinline__ void fin(Acc& acc, const Seg& s, int wr, int wc, int fr, int fq) const {
        f32x4 b0[2], b1[2];
#pragma unroll
        for (int bj = 0; bj < 2; ++bj) { const int c = EPI_C(s, bj); b0[bj] = *(const f32x4*)(bias + c); b1[bj] = *(const f32x4*)(bias + c + 4); }
#pragma unroll
        for (int aim = 0; aim < 4; ++aim) { const int ai = aim >> 1, mh = aim & 1;
            u32x4 gw[2][2], sw[2][2];
#pragma unroll
            for (int mm = 0; mm < 2; ++mm)
#pragma unroll
                for (int bj = 0; bj < 2; ++bj) { const int m = mh * 2 + mm; const int r = EPI_R(s), c = EPI_C(s, bj); gw[mm][bj] = *(const u32x4*)(GY + (size_t)r * 512 + c); sw[mm][bj] = *(const u32x4*)(YY + (size_t)r * 1536 + c); }
#pragma unroll
            for (int mm = 0; mm < 2; ++mm)
#pragma unroll
                for (int bj = 0; bj < 2; ++bj) { const int m = mh * 2 + mm; const int r = EPI_R(s), c = EPI_C(s, bj); f32x4 g0, g1, s0, s1; unpack8(gw[mm][bj], g0, g1); unpack8(sw[mm][bj], s0, s1); s0 = s0 * sigm4(s0); s1 = s1 * sigm4(s1);
                    const f32x4 v0 = g0 * sigm4(acc[ai][bj][m][0] + b0[bj]) * s0, v1 = g1 * sigm4(acc[ai][bj][m][1] + b1[bj]) * s1;
                    *(u32x4*)(YY + (size_t)r * 1536 + c) = pack8(v0, v1); }
            asm volatile("" ::: "memory");
        }
    }
};
struct EpiMerge {
    static constexpr bool AFTER_DRAIN = false;
    const bf16_t* __restrict__ GS; bf16_t* A6;
    __device__ __forceinline__ void mid(Acc& acc, const Seg& s, int wr, int wc, int fr, int fq) const {
#pragma unroll
        for (int ai = 0; ai < 2; ++ai) {
            u32x4 aw[4][2];
#pragma unroll
            for (int m = 0; m < 4; ++m)
#pragma unroll
                for (int bj = 0; bj < 2; ++bj) aw[m][bj] = *(const u32x4*)(GS + (size_t)EPI_R(s) * 1024 + EPI_C(s, bj));
#pragma unroll
            for (int m = 0; m < 4; ++m)
#pragma unroll
                for (int bj = 0; bj < 2; ++bj) { f32x4 a0, a1; unpack8(aw[m][bj], a0, a1); acc[ai][bj][m][0] *= a0; acc[ai][bj][m][1] *= a1; }
            asm volatile("" ::: "memory");
        }
    }
    __device__ __forceinline__ void fin(Acc& acc, const Seg& s, int wr, int wc, int fr, int fq) const {
#pragma unroll
        for (int ai = 0; ai < 2; ++ai) {
            u32x4 bw[4][2];
#pragma unroll
            for (int m = 0; m < 4; ++m)
#pragma unroll
                for (int bj = 0; bj < 2; ++bj) bw[m][bj] = *(const u32x4*)(A6 + (size_t)EPI_R(s) * 1280 + 256 + EPI_C(s, bj));
#pragma unroll
            for (int m = 0; m < 4; ++m)
#pragma unroll
                for (int bj = 0; bj < 2; ++bj) { f32x4 b0, b1; unpack8(bw[m][bj], b0, b1);
#pragma unroll
                    for (int e = 0; e < 4; ++e) { b0[e] = __builtin_amdgcn_rcpf(b0[e]); b1[e] = __builtin_amdgcn_rcpf(b1[e]); }
                    *(u32x4*)(A6 + (size_t)EPI_R(s) * 1280 + 256 + EPI_C(s, bj)) = pack8(acc[ai][bj][m][0] * b0, acc[ai][bj][m][1] * b1); }
            asm volatile("" ::: "memory");
        }
    }
};
struct EpiOut {
    static constexpr bool AFTER_DRAIN = false;
    const bf16_t* __restrict__ PG; const float* __restrict__ x; float* __restrict__ out; f32x2* __restrict__ stats;
    __device__ __forceinline__ void mid(Acc& acc, const Seg& s, int wr, int wc, int fr, int fq) const {
#pragma unroll
        for (int ai = 0; ai < 2; ++ai) {
            u32x4 aw[4][2];
#pragma unroll
            for (int m = 0; m < 4; ++m)
#pragma unroll
                for (int bj = 0; bj < 2; ++bj) aw[m][bj] = *(const u32x4*)(PG + (size_t)EPI_R(s) * 1024 + EPI_C(s, bj));
#pragma unroll
            for (int m = 0; m < 4; ++m)
#pragma unroll
                for (int bj = 0; bj < 2; ++bj) { f32x4 a0, a1; unpack8(aw[m][bj], a0, a1); acc[ai][bj][m][0] *= a0; acc[ai][bj][m][1] *= a1; }
            asm volatile("" ::: "memory");
        }
    }
    __device__ __forceinline__ void fin(Acc& acc, const Seg& s, int wr, int wc, int fr, int fq) const {
#pragma unroll
        for (int aim = 0; aim < 4; ++aim) { const int ai = aim >> 1, mh = aim & 1;
            f32x4 xv[2][2][2];
#pragma unroll
            for (int mm = 0; mm < 2; ++mm)
#pragma unroll
                for (int bj = 0; bj < 2; ++bj) { const int m = mh * 2 + mm; const float* xp = x + (size_t)EPI_R(s) * 1024 + EPI_C(s, bj); xv[mm][bj][0] = __builtin_nontemporal_load((const f32x4*)xp); xv[mm][bj][1] = __builtin_nontemporal_load((const f32x4*)(xp + 4)); }
#pragma unroll
            for (int mm = 0; mm < 2; ++mm) { const int m = mh * 2 + mm; const int r = EPI_R(s); float s1 = 0.f, s2 = 0.f;
#pragma unroll
                for (int bj = 0; bj < 2; ++bj) { float* op = out + (size_t)r * 1024 + EPI_C(s, bj);
                    const f32x4 h0 = xv[mm][bj][0] * ALPHA + acc[ai][bj][m][0], h1 = xv[mm][bj][1] * ALPHA + acc[ai][bj][m][1];
                    *(f32x4*)op = h0; *(f32x4*)(op + 4) = h1;
                    s1 += (h0[0] + h0[1]) + (h0[2] + h0[3]) + (h1[0] + h1[1]) + (h1[2] + h1[3]);
                    s2 += (h0[0] * h0[0] + h0[1] * h0[1]) + (h0[2] * h0[2] + h0[3] * h0[3]) + (h1[0] * h1[0] + h1[1] * h1[1]) + (h1[2] * h1[2] + h1[3] * h1[3]); }
                s1 += __shfl_xor(s1, 16); s1 += __shfl_xor(s1, 32); s2 += __shfl_xor(s2, 16); s2 += __shfl_xor(s2, 32);
                if (fq == 0) stats[(size_t)r * 16 + s.pn * 4 + wc] = (f32x2){s1, s2}; }
            asm volatile("" ::: "memory");
        }
    }
};
struct EpiOutLn {
    static constexpr bool AFTER_DRAIN = true;
    const bf16_t* __restrict__ PG; const float* __restrict__ x; float* __restrict__ out; const float* __restrict__ lg; const float* __restrict__ lb;
    unsigned long long* xbuf; unsigned* cnt; unsigned* tmo;
    __device__ __forceinline__ void mid(Acc& acc, const Seg& s, int wr, int wc, int fr, int fq) const {
#pragma unroll
        for (int ai = 0; ai < 2; ++ai) {
            u32x4 aw[4][2];
#pragma unroll
            for (int m = 0; m < 4; ++m)
#pragma unroll
                for (int bj = 0; bj < 2; ++bj) aw[m][bj] = *(const u32x4*)(PG + (size_t)EPI_R(s) * 1024 + EPI_C(s, bj));
#pragma unroll
            for (int m = 0; m < 4; ++m)
#pragma unroll
                for (int bj = 0; bj < 2; ++bj) { f32x4 a0, a1; unpack8(aw[m][bj], a0, a1); acc[ai][bj][m][0] *= a0; acc[ai][bj][m][1] *= a1; }
            asm volatile("" ::: "memory");
        }
    }
    __device__ __forceinline__ void fin(Acc&, const Seg&, int, int, int, int) const {}
    __device__ __forceinline__ void fused(Acc& acc, const Seg& s, int wr, int wc, int fr, int fq, LAS unsigned char* lds) const {
        LAS f32x2* Pt = (LAS f32x2*)lds;
        LAS f32x2* St = (LAS f32x2*)(lds + 8192);
        const int tl = tid_local(), wid = tl >> 6, lane = tl & 63;
#pragma unroll
        for (int aim = 0; aim < 4; ++aim) { const int ai = aim >> 1, mh = aim & 1;
            f32x4 xv[2][2][2];
#pragma unroll
            for (int mm = 0; mm < 2; ++mm)
#pragma unroll
                for (int bj = 0; bj < 2; ++bj) { const int m = mh * 2 + mm; const float* xp = x + (size_t)EPI_R(s) * 1024 + EPI_C(s, bj); xv[mm][bj][0] = __builtin_nontemporal_load((const f32x4*)xp); xv[mm][bj][1] = __builtin_nontemporal_load((const f32x4*)(xp + 4)); }
#pragma unroll
            for (int mm = 0; mm < 2; ++mm) { const int m = mh * 2 + mm; float s1 = 0.f, s2 = 0.f;
#pragma unroll
                for (int bj = 0; bj < 2; ++bj) { const f32x4 h0 = xv[mm][bj][0] * ALPHA + acc[ai][bj][m][0], h1 = xv[mm][bj][1] * ALPHA + acc[ai][bj][m][1];
                    acc[ai][bj][m][0] = h0; acc[ai][bj][m][1] = h1;
                    s1 += (h0[0] + h0[1]) + (h0[2] + h0[3]) + (h1[0] + h1[1]) + (h1[2] + h1[3]);
                    s2 += (h0[0] * h0[0] + h0[1] * h0[1]) + (h0[2] * h0[2] + h0[3] * h0[3]) + (h1[0] * h1[0] + h1[1] * h1[1]) + (h1[2] * h1[2] + h1[3] * h1[3]); }
                s1 += __shfl_xor(s1, 16); s1 += __shfl_xor(s1, 32); s2 += __shfl_xor(s2, 16); s2 += __shfl_xor(s2, 32);
                if (fq == 0) Pt[(ai * 128 + wr * 64 + m * 16 + fr) * 4 + wc] = (f32x2){s1, s2}; }
            asm volatile("" ::: "memory"); __builtin_amdgcn_sched_barrier(0);
        }
        __syncthreads();
        const int row = wid * 32 + (lane & 31);
        if (lane < 32) { const f32x2 a = Pt[row * 4 + 0], b = Pt[row * 4 + 1], c = Pt[row * 4 + 2], d = Pt[row * 4 + 3];
            const float t1 = (a.x + b.x) + (c.x + d.x), t2 = (a.y + b.y) + (c.y + d.y);
            __hip_atomic_store(xbuf + ((size_t)(s.pm * 256 + row) * 4 + s.pn), ((unsigned long long)__float_as_uint(t2) << 32) | __float_as_uint(t1), __ATOMIC_RELAXED, __HIP_MEMORY_SCOPE_AGENT); }
        asm volatile("s_waitcnt vmcnt(0)" ::: "memory");
        if (lane == 0) __hip_atomic_fetch_add(cnt + 64 * s.pm, 1u, __ATOMIC_RELAXED, __HIP_MEMORY_SCOPE_AGENT);
        if (wid == 0) { unsigned sp = 0;
            while ((unsigned)__builtin_amdgcn_readfirstlane(__hip_atomic_load(cnt + 64 * s.pm, __ATOMIC_RELAXED, __HIP_MEMORY_SCOPE_AGENT)) < 32u) {
                __builtin_amdgcn_s_sleep(1);
                if ((++sp & 255u) == 0u) { if (xb_ld(tmo)) break; if (sp > XB_SPIN_CAP) { if (lane == 0) atomicAdd(tmo, 1u); break; } } }
            __builtin_amdgcn_fence(__ATOMIC_ACQUIRE, "agent"); }
        asm volatile("s_waitcnt vmcnt(0) lgkmcnt(0)" ::: "memory");
        __syncthreads();
        if (lane < 32) { float t1 = 0.f, t2 = 0.f;
#pragma unroll
            for (int t = 0; t < 4; ++t) { const unsigned long long w = __hip_atomic_load(xbuf + ((size_t)(s.pm * 256 + row) * 4 + t), __ATOMIC_RELAXED, __HIP_MEMORY_SCOPE_AGENT); t1 += __uint_as_float((unsigned)w); t2 += __uint_as_float((unsigned)(w >> 32)); }
            const float mean = t1 * (1.0f / 1024.0f), var = fmaxf(t2 * (1.0f / 1024.0f) - mean * mean, 0.f);
            St[row] = (f32x2){mean, 1.0f / sqrtf(var + LN_EPS)}; }
        __syncthreads();
        f32x4 g0[2], g1[2], b0[2], b1[2];
#pragma unroll
        for (int bj = 0; bj < 2; ++bj) { const int c = EPI_C(s, bj); g0[bj] = *(const f32x4*)(lg + c); g1[bj] = *(const f32x4*)(lg + c + 4); b0[bj] = *(const f32x4*)(lb + c); b1[bj] = *(const f32x4*)(lb + c + 4); }
#pragma unroll
        for (int ai = 0; ai < 2; ++ai)
#pragma unroll
            for (int m = 0; m < 4; ++m) { const int rl = ai * 128 + wr * 64 + m * 16 + fr; const f32x2 sr = St[rl]; const float nb = -sr.x * sr.y;
#pragma unroll
                for (int bj = 0; bj < 2; ++bj) { float* op = out + (size_t)EPI_R(s) * 1024 + EPI_C(s, bj);
                    const f32x4 o0 = (acc[ai][bj][m][0] * sr.y + nb) * g0[bj] + b0[bj], o1 = (acc[ai][bj][m][1] * sr.y + nb) * g1[bj] + b1[bj];
                    *(f32x4*)op = o0; *(f32x4*)(op + 4) = o1; } }
        __syncthreads();
    }
};
}

__device__ __forceinline__ void tconv_tile(LAS float* t, const float* in, int ld_in, bf16_t* out, int ld_out, int k0, int n0) {
    const int tid = tid_local();
    { const int kr = tid >> 4, c4 = tid & 15;
#pragma unroll
      for (int ps = 0; ps < 2; ++ps) { const int k = kr + ps * 32; const f32x4 v = *(const f32x4*)(in + (size_t)(k0 + k) * ld_in + n0 + c4 * 4);
          t[k * 65 + c4 * 4 + 0] = v[0]; t[k * 65 + c4 * 4 + 1] = v[1]; t[k * 65 + c4 * 4 + 2] = v[2]; t[k * 65 + c4 * 4 + 3] = v[3]; } }
    __syncthreads();
    { const int nr = tid >> 3, k8 = tid & 7; f32x4 a, b;
#pragma unroll
      for (int e = 0; e < 4; ++e) { a[e] = t[(k8 * 8 + e) * 65 + nr]; b[e] = t[(k8 * 8 + 4 + e) * 65 + nr]; }
      *(u32x4*)(out + (size_t)(n0 + nr) * ld_out + k0 + k8 * 8) = pack8(a, b); }
    __syncthreads();
}

__device__ __forceinline__ void prep_a(LAS unsigned char* lds, const Params& P, int bid, int G) {
    unsigned char* ws = P.ws; const int tid = tid_local();
    bf16_t* WT1 = (bf16_t*)(ws + OFF_WT1); bf16_t* WINP = (bf16_t*)(ws + OFF_WINP); bf16_t* PWT = (bf16_t*)(ws + OFF_PWT); bf16_t* GLT = (bf16_t*)(ws + OFF_GLT);
    bf16_t* W5 = (bf16_t*)(ws + OFF_W5); bf16_t* W6 = (bf16_t*)(ws + OFF_W6); bf16_t* WT2 = (bf16_t*)(ws + OFF_WT2); bf16_t* BT3 = (bf16_t*)(ws + OFF_BT3);
    float* KTAB = (float*)(ws + OFF_KTAB); f32x2* AL = (f32x2*)(ws + OFF_AL);
    for (int task = bid; task < 256; task += G) {
        const int g = task >> 3, q = task & 7;
        LAS f32x2* PW = (LAS f32x2*)lds;
        LAS f32x2* Bb = PW + 33 * 64;
        LAS f32x2* Cc = Bb + 64 * 16;
        const float* a_re = P.in[5] + g * 64; const float* a_im = P.in[6] + g * 64; const float dt = expf(P.in[7][g]);
        for (int e = tid; e < 33 * 64; e += NTHR) { const int j = e >> 6, p = e & 63; const float lr = a_re[p], li = a_im[p];
            const float mag = expf(lr * dt * (float)j);
            double rev = (double)li * (double)dt * (double)j * 0.15915494309189535; rev -= floor(rev); const float rv = (float)rev;
            PW[e] = (f32x2){mag * __builtin_amdgcn_cosf(rv), mag * __builtin_amdgcn_sinf(rv)}; }
        __syncthreads();
        for (int e = tid; e < 1024; e += NTHR) { const int p = e >> 4, h = e & 15; const float lr = a_re[p], li = a_im[p]; const f32x2 ab = PW[64 + p];
            const float xr = ab.x - 1.0f, xi = ab.y, den = lr * lr + li * li;
            const float zr = (xr * lr + xi * li) / den, zi = (xi * lr - xr * li) / den;
            const float br = P.in[8][(size_t)(g * 64 + p) * 16 + h], bi = P.in[9][(size_t)(g * 64 + p) * 16 + h];
            Bb[e] = (f32x2){zr * br - zi * bi, zr * bi + zi * br};
            Cc[e] = (f32x2){P.in[10][(size_t)g * 1024 + e], P.in[11][(size_t)g * 1024 + e]}; }
        __syncthreads();
        for (int e = tid; e < 1024; e += NTHR) { const int j = 4 * q + (e >> 8), h = (e >> 4) & 15, h2 = e & 15; float a = 0.f;
            for (int p = 0; p < 64; ++p) { const f32x2 w = PW[j * 64 + p], bb = Bb[p * 16 + h2], cc = Cc[h * 64 + p];
                const float wr_ = w.x * bb.x - w.y * bb.y, wi_ = w.x * bb.y + w.y * bb.x; a += cc.x * wr_ - cc.y * wi_; }
            KTAB[((size_t)(g * 32 + j) * 16 + h) * 16 + h2] = a; }
        for (int v = tid; v < 2048; v += NTHR) { const int n = v >> 3, k0 = 64 * q + (v & 7) * 8, sx = k0 >> 4, h0 = k0 & 15; f32x4 a = {0.f, 0.f, 0.f, 0.f}, b = {0.f, 0.f, 0.f, 0.f};
            if (n < 128) { const int p = n & 63; const bool im = n >= 64; const f32x2 w = PW[(31 - sx) * 64 + p];
#pragma unroll
                for (int e = 0; e < 8; ++e) { const f32x2 bb = Bb[p * 16 + h0 + e]; const float val = im ? (w.x * bb.y + w.y * bb.x) : (w.x * bb.x - w.y * bb.y); if (e < 4) a[e] = val; else b[e - 4] = val; } }
            *(u32x4*)(WT2 + (size_t)(g * 256 + n) * 512 + k0) = pack8(a, b); }
        for (int v = tid; v < 1024; v += NTHR) { const int n = 64 * q + (v >> 4), t = n >> 4, h = n & 15, k0 = (v & 15) * 8; const bool im = k0 >= 64; const int p0 = k0 & 63; f32x4 a, b;
#pragma unroll
            for (int e = 0; e < 8; ++e) { const int p = p0 + e; const f32x2 w = PW[(t + 1) * 64 + p], cc = Cc[h * 64 + p];
                const float val = im ? -(cc.x * w.y + cc.y * w.x) : (cc.x * w.x - cc.y * w.y); if (e < 4) a[e] = val; else b[e - 4] = val; }
            *(u32x4*)(BT3 + (size_t)(g * 512 + n) * 640 + 512 + k0) = pack8(a, b); }
        if (q == 0 && tid < 64) AL[g * 64 + tid] = PW[32 * 64 + tid];
        __syncthreads();
    }
    LAS float* tt = (LAS float*)lds;
#define TC_JOB(x) \
        const float* in; int ld_in, ld_out, nT, xx; bf16_t* out; float wsc = 1.0f; int pcol = -1; \
        if ((x) < 1280)      { xx = (x);        in = P.in[2] + 1024; ld_in = 6144; out = WT1 + (size_t)1024 * 1024; ld_out = 1024; nT = 80; } \
        else if ((x) < 1344) { xx = (x) - 1280; in = P.in[13];       ld_in = 512;  out = GLT;       ld_out = 512;  nT = 8; } \
        else if ((x) < 1472) { xx = (x) - 1344; in = P.in[16];       ld_in = 1024; out = W5;        ld_out = 1536; nT = 16; } \
        else if ((x) < 1728) { xx = (x) - 1472; in = P.in[15];       ld_in = 1024; out = W5 + 512;  ld_out = 1536; nT = 16; } \
        else if ((x) < 1792) { xx = (x) - 1728; in = P.in[18];       ld_in = 1024; out = W6;        ld_out = 1280; nT = 16; } \
        else if ((x) < 2048) { xx = (x) - 1792; in = P.in[17];       ld_in = 1024; out = W6 + 256;  ld_out = 1280; nT = 16; } \
        else                 { xx = (x) - 2048; in = P.in[3];        ld_in = 256;  out = PWT;       ld_out = 1024; nT = 4; } \
        const int k0 = (xx / nT) * 64, n0 = (xx % nT) * 64; if ((x) < 1280 && n0 >= 2048) wsc = -1.4426950408889634f;     \
        if ((x) < 1280 && n0 >= 2048 && n0 < 4096) { const int j = (n0 - 2048) >> 6; pcol = 3072 + (j >> 2) * 128 + (j & 3) * 32; }     \
        (void)in; (void)ld_in; (void)out; (void)ld_out; (void)wsc; (void)pcol;
    for (int xb = bid; xb < 2112; xb += 5 * G) {
        f32x4 v[5][2];
        const int kr = tid >> 4, c4 = tid & 15;
#pragma unroll
        for (int j = 0; j < 5; ++j) { const int x = xb + j * G; if (x < 2112) { TC_JOB(x)
#pragma unroll
            for (int ps = 0; ps < 2; ++ps) { const float* src = (pcol < 0) ? in + (size_t)(k0 + kr + ps * 32) * ld_in + n0 + c4 * 4 : P.in[2] + (size_t)(k0 + kr + ps * 32) * 6144 + (c4 < 8 ? pcol + c4 * 4 : pcol + 1024 + (c4 - 8) * 4);
                v[j][ps] = *(const f32x4*)src; } } }
#pragma unroll
        for (int j = 0; j < 5; ++j) { const int x = xb + j * G; if (x < 2112) { LAS float* t = tt + j * (64 * 65);
#pragma unroll
            for (int ps = 0; ps < 2; ++ps) { const int k = kr + ps * 32; t[k * 65 + c4 * 4 + 0] = v[j][ps][0]; t[k * 65 + c4 * 4 + 1] = v[j][ps][1]; t[k * 65 + c4 * 4 + 2] = v[j][ps][2]; t[k * 65 + c4 * 4 + 3] = v[j][ps][3]; } } }
        __syncthreads();
        const int nr = tid >> 3, k8 = tid & 7;
#pragma unroll
        for (int j = 0; j < 5; ++j) { const int x = xb + j * G; if (x < 2112) { TC_JOB(x) const LAS float* t = tt + j * (64 * 65); f32x4 a, b;
#pragma unroll
            for (int e = 0; e < 4; ++e) { a[e] = t[(k8 * 8 + e) * 65 + nr] * wsc; b[e] = t[(k8 * 8 + 4 + e) * 65 + nr] * wsc; }
            *(u32x4*)(out + (size_t)(n0 + nr) * ld_out + k0 + k8 * 8) = pack8(a, b); } }
        __syncthreads();
    }
#undef TC_JOB
    for (int v = bid * NTHR + tid; v < 1024 * 128; v += G * NTHR) { const int d = v >> 7, i0 = (v & 127) * 8; const float* src = P.in[2] + (size_t)d * 6144 + i0;
        *(u32x4*)(WINP + (size_t)d * 1024 + i0) = pack8(*(const f32x4*)src, *(const f32x4*)(src + 4)); }
}

__device__ __forceinline__ void fold_prelude(LAS unsigned char* lds, const Params& P, int f) {
    unsigned char* ws = P.ws; const int tid = tid_local(); const int g = f >> 2, pn = f & 3;
    bf16_t* WINP = (bf16_t*)(ws + OFF_WINP); bf16_t* PWT = (bf16_t*)(ws + OFF_PWT);
    LAS float* tt = (LAS float*)lds;
    for (int x = 0; x < 16; ++x) tconv_tile(tt, P.in[3], 256, PWT, 1024, (4 * g + (x >> 2)) * 64, (x & 3) * 64);
    for (int v = tid; v < 8192; v += NTHR) { const int d = 256 * pn + (v >> 5), i0 = 256 * g + (v & 31) * 8; const float* src = P.in[2] + (size_t)d * 6144 + i0;
        *(u32x4*)(WINP + (size_t)d * 1024 + i0) = pack8(*(const f32x4*)src, *(const f32x4*)(src + 4)); }
    asm volatile("s_waitcnt vmcnt(0)" ::: "memory");
    __syncthreads();
}

__device__ __forceinline__ void prep_b_stream(const Params& P, int bi, int nb) {
    unsigned char* ws = P.ws; const size_t gt = (size_t)bi * NTHR + tid_local(), gn = (size_t)nb * NTHR;
    bf16_t* BT3 = (bf16_t*)(ws + OFF_BT3); const float* KTAB = (const float*)(ws + OFF_KTAB); bf16_t* XB = (bf16_t*)(ws + OFF_XB); bf16_t* A6 = (bf16_t*)(ws + OFF_A6);
    { const float* x = P.in[0]; const size_t N = (size_t)T * 128;
      for (size_t v = gt; v < N; v += 8 * gn) { f32x4 a[8], b[8];
#pragma unroll
          for (int u = 0; u < 8; ++u) { const size_t i = v + u * gn; if (i < N) { a[u] = __builtin_nontemporal_load((const f32x4*)(x + i * 8)); b[u] = __builtin_nontemporal_load((const f32x4*)(x + i * 8 + 4)); } }
#pragma unroll
          for (int u = 0; u < 8; ++u) { const size_t i = v + u * gn; if (i < N) *(u32x4*)(XB + i * 8) = pack8(a[u], b[u]); } } }
}

__device__ __forceinline__ void p_convert(const Params& P, int bi, int nb) {
    const size_t gt = (size_t)bi * NTHR + tid_local(), gn = (size_t)nb * NTHR; bf16_t* A6 = (bf16_t*)(P.ws + OFF_A6);
    { const float* p = P.in[1]; const size_t N = (size_t)T * 32;
      for (size_t v = gt; v < N; v += 8 * gn) { f32x4 a[8], b[8];
#pragma unroll
          for (int u = 0; u < 8; ++u) { const size_t i = v + u * gn; if (i < N) { a[u] = __builtin_nontemporal_load((const f32x4*)(p + i * 8)); b[u] = __builtin_nontemporal_load((const f32x4*)(p + i * 8 + 4)); } }
#pragma unroll
          for (int u = 0; u < 8; ++u) { const size_t i = v + u * gn; if (i < N) { const size_t r = i >> 5; const int c = (int)(i & 31) * 8; *(u32x4*)(A6 + r * 1280 + c) = pack8(a[u], b[u]); } } } }
}

__device__ __forceinline__ void bt3_expand(const Params& P, int bi, int nb) {
    unsigned char* ws = P.ws; const size_t gt = (size_t)bi * NTHR + tid_local(), gn = (size_t)nb * NTHR;
    bf16_t* BT3 = (bf16_t*)(ws + OFF_BT3); const float* KTAB = (const float*)(ws + OFF_KTAB);
    { const size_t N = (size_t)32 * 512 * 64;
      for (size_t v0 = gt; v0 < N; v0 += 8 * gn) { f32x4 a[8], b[8];
#pragma unroll
          for (int u = 0; u < 8; ++u) { const size_t v = v0 + u * gn; a[u] = (f32x4){0.f, 0.f, 0.f, 0.f}; b[u] = a[u];
              if (v < N) { const int kv = (int)(v & 63), n = (int)((v >> 6) & 511), g = (int)(v >> 15); const int t = n >> 4, h = n & 15, k0 = kv * 8, sx = k0 >> 4, h0 = k0 & 15;
                  if (sx <= t) { const float* src = KTAB + ((size_t)(g * 32 + (t - sx)) * 16 + h) * 16 + h0; a[u] = *(const f32x4*)src; b[u] = *(const f32x4*)(src + 4); } } }
#pragma unroll
          for (int u = 0; u < 8; ++u) { const size_t v = v0 + u * gn;
              if (v < N) { const int kv = (int)(v & 63), n = (int)((v >> 6) & 511), g = (int)(v >> 15); *(u32x4*)(BT3 + (size_t)(g * 512 + n) * 640 + kv * 8) = pack8(a[u], b[u]); } } } }
}

template <int W>
__device__ __forceinline__ void pool_run(const bf16_t* Z, bf16_t* YY, const float* scale, int t0, int c) {
    constexpr int NR = W + 7;
    const int pos0 = t0 & 2047;
    u32x4 rows[NR], gts[8];
#pragma unroll
    for (int j = 0; j < NR; ++j) { const int d = j - (W - 1); const bool ok = (pos0 + d) >= 0; const int tk = ok ? t0 + d : t0;
        u32x4 w = *(const u32x4*)(Z + (size_t)tk * 1024 + c); if (!ok) w = (u32x4){0u, 0u, 0u, 0u}; rows[j] = w; }
    bf16_t* yp = YY + (size_t)t0 * 1536 + 512 + c;
#pragma unroll
    for (int i = 0; i < 8; ++i) gts[i] = *(const u32x4*)(yp + (size_t)i * 1536);
    const f32x4 sc0 = *(const f32x4*)(scale + c), sc1 = *(const f32x4*)(scale + c + 4);
    f32x4 s0 = {0.f, 0.f, 0.f, 0.f}, s1 = {0.f, 0.f, 0.f, 0.f};
#pragma unroll
    for (int j = 0; j < W; ++j) { f32x4 a, b; unpack8(rows[j], a, b); s0 += a; s1 += b; }
#pragma unroll
    for (int i = 0; i < 8; ++i) {
        const int n = (pos0 + i + 1 < W) ? pos0 + i + 1 : W; const float inv = 1.0f / (float)n;
        f32x4 z0, z1, g0, g1; unpack8(rows[i + W - 1], z0, z1); unpack8(gts[i], g0, g1); g0 = g0 * sigm4(g0); g1 = g1 * sigm4(g1);
        *(u32x4*)(yp + (size_t)i * 1536) = pack8((s0 * inv - z0) * sc0 * g0, (s1 * inv - z1) * sc1 * g1);
        if (i < 7) { f32x4 a, b; unpack8(rows[i], a, b); s0 -= a; s1 -= b; unpack8(rows[i + W], a, b); s0 += a; s1 += b; }
    }
}
__device__ __forceinline__ void pool_pass(const Params& P, int wv, int nwv, int item0, int nitems) {
    const bf16_t* Z = (const bf16_t*)P.out; bf16_t* YY = (bf16_t*)(P.ws + OFF_YY); const float* scale = P.in[4];
    const int lane = tid_local() & 63;
    for (int it = wv; it < nitems; it += nwv) { const int item = item0 + it;
        const int gi = item / (T / 16), tr = item % (T / 16); const int t0 = (tr * 2 + (lane >> 5)) * 8, c = gi * 256 + (lane & 31) * 8;
        if (gi == 0) pool_run<2>(Z, YY, scale, t0, c); else if (gi == 1) pool_run<4>(Z, YY, scale, t0, c); else if (gi == 2) pool_run<8>(Z, YY, scale, t0, c); else pool_run<16>(Z, YY, scale, t0, c);
    }
}

__device__ __forceinline__ void ln_pass(const Params& P) {
    const f32x2* stats = (const f32x2*)(P.ws + OFF_STATS); float* out = P.out; const float* lg = P.in[19]; const float* lb = P.in[20];
    const int tl = tid_local(); const int lane = tl & 63, wv = blockIdx.x * (NTHR / 64) + (tl >> 6), nwv = gridDim.x * (NTHR / 64);
    f32x4 gg[4], bb[4];
#pragma unroll
    for (int i = 0; i < 4; ++i) { gg[i] = *(const f32x4*)(lg + i * 256 + lane * 4); bb[i] = *(const f32x4*)(lb + i * 256 + lane * 4); }
    for (int r0 = wv * 4; r0 < T; r0 += nwv * 4) {
        f32x4 h[4][4];
#pragma unroll
        for (int q = 0; q < 4; ++q)
#pragma unroll
            for (int i = 0; i < 4; ++i) h[q][i] = *(const f32x4*)(out + (size_t)(r0 + q) * 1024 + i * 256 + lane * 4);
        const f32x2 st = stats[(size_t)(r0 + (lane >> 4)) * 16 + (lane & 15)];
        float s1 = st.x, s2 = st.y;
#pragma unroll
        for (int o = 1; o < 16; o <<= 1) { s1 += __shfl_xor(s1, o); s2 += __shfl_xor(s2, o); }
#pragma unroll
        for (int q = 0; q < 4; ++q) {
            const float a1 = __shfl(s1, q * 16), a2 = __shfl(s2, q * 16);
            const float mu = a1 * (1.0f / 1024.0f); const float var = fmaxf(a2 * (1.0f / 1024.0f) - mu * mu, 0.f); const float rstd = 1.0f / sqrtf(var + LN_EPS);
#pragma unroll
            for (int i = 0; i < 4; ++i) { const f32x4 o = (h[q][i] - mu) * rstd * gg[i] + bb[i]; __builtin_nontemporal_store(o, (f32x4*)(out + (size_t)(r0 + q) * 1024 + i * 256 + lane * 4)); }
        }
    }
}

__global__ void __launch_bounds__(NTHR, 2) mega(Params P) {
    extern __shared__ __attribute__((aligned(16))) unsigned char lds_raw[];
    LAS unsigned char* lds = (LAS unsigned char*)lds_raw;
    unsigned char* ws = P.ws; const int G = gridDim.x, bid = blockIdx.x;
    bf16_t* XB = (bf16_t*)(ws + OFF_XB); bf16_t* GY = XB; bf16_t* YY = (bf16_t*)(ws + OFF_YY); bf16_t* A6 = (bf16_t*)(ws + OFF_A6); bf16_t* PG = (bf16_t*)(ws + OFF_PG);
    bf16_t* UA = (bf16_t*)(ws + OFF_UA); bf16_t* WT1 = (bf16_t*)(ws + OFF_WT1); bf16_t* WINP = (bf16_t*)(ws + OFF_WINP); bf16_t* PWT = (bf16_t*)(ws + OFF_PWT);
    bf16_t* GLT = (bf16_t*)(ws + OFF_GLT); bf16_t* W5 = (bf16_t*)(ws + OFF_W5); bf16_t* W6 = (bf16_t*)(ws + OFF_W6); bf16_t* WT2 = (bf16_t*)(ws + OFF_WT2); bf16_t* BT3 = (bf16_t*)(ws + OFF_BT3);
    bf16_t* Z = (bf16_t*)P.out; bf16_t* GS = Z + (size_t)T * 1024;
    if (threadIdx.x < 16) ((LAS unsigned*)(lds + LDS_STAGE))[threadIdx.x] = 0u;
    __syncthreads();
    const XcdBarrier gbar = xcd_barrier_post((unsigned*)(ws + OFF_CTL), (volatile LAS unsigned*)(lds + LDS_STAGE));
    if (ws == nullptr) cg::this_grid().sync();
#define GRID_BAR() xcd_barrier(gbar)
    const int xc = (G % 8 == 0) ? (bid % 8) * (G / 8) + bid / 8 : bid;

    if (G == 256) {
        if (bid < 88) prep_a(lds, P, bid, 88);
        else if (bid < 104) { fold_prelude(lds, P, bid - 88);
            pg8::Sched S{(const char*)PWT, (const char*)WINP, 512, 512, 1024, 1024, 1, 4, 4, 1, 0, 0, 4, 0, 0, 0, 16, bid - 88, 1};
            pg8::EpiFold E{WT1}; pg8::gemm_phase(lds, S, E); }
        else prep_b_stream(P, bid - 104, 152);
    } else {
        prep_a(lds, P, bid, G);
        GRID_BAR();
        { pg8::Sched S{(const char*)PWT, (const char*)WINP, 512, 512, 1024, 1024, 1, 4, 4, 1, 0, 0, 4, 0, 0, 0, G, bid, 1};
          pg8::EpiFold E{WT1}; pg8::gemm_phase(lds, S, E); }
        prep_b_stream(P, bid, G);
    }
    GRID_BAR();
    bt3_expand(P, bid, G);
    { pg8::Sched S{(const char*)XB, (const char*)WT1, 0, 0, 1024, 1024, 128, 24, 1, 1, 0, 0, 16, 0, 0, 0, G, bid, 0};
      pg8::EpiProj E{Z, YY, UA, A6, GS, PG}; pg8::gemm_phase(lds, S, E); }
    GRID_BAR();
    { pg8::Sched S{(const char*)UA, (const char*)WT2, (size_t)1024 * 640 * 2, (size_t)256 * 512 * 2, 640, 512, 4, 1, 32, 1, 0, 0, 8, 0, 0, 0, G, bid, 1};
      pg8::EpiState E{UA, (const f32x2*)(ws + OFF_AL)}; pg8::gemm_phase(lds, S, E);
      const int wv_in_blk = tid_local() >> 6; const int NIT = 4 * (T / 16);
      if (G == 256) { if (bid >= 128) pool_pass(P, (bid - 128) * 8 + wv_in_blk, 1024, 0, (NIT * 3) / 4); else pool_pass(P, bid * 8 + wv_in_blk, 1024, (NIT * 3) / 4, NIT / 4); }
      else pool_pass(P, bid * 8 + wv_in_blk, G * 8, 0, NIT); }
    GRID_BAR();
    { pg8::Sched S{(const char*)UA, (const char*)BT3, (size_t)1024 * 640 * 2, (size_t)512 * 640 * 2, 640, 640, 4, 2, 32, 1, 0, 0, 10, 0, 0, 0, G, xc, 1};
      pg8::EpiS5Out E{UA, P.in[12], GY}; pg8::gemm_phase(lds, S, E); }
    GRID_BAR();
    { pg8::Sched S{(const char*)GY, (const char*)GLT, 0, 0, 512, 512, 128, 2, 1, 1, 0, 0, 8, 0, 0, 0, G, bid, 0};
      pg8::EpiGlu E{GY, P.in[14], YY}; pg8::gemm_phase(lds, S, E); }
    GRID_BAR();
    if (bid & 1) p_convert(P, bid >> 1, G >> 1);
    { pg8::Sched S{(const char*)YY, (const char*)W5, 0, 0, 1536, 1536, 128, 4, 1, 2, 0, 0, 8, 512, 512, 16, G, bid, 0};
      pg8::EpiMerge E{GS, A6}; pg8::gemm_phase(lds, S, E); }
    GRID_BAR();
    { pg8::EpiOutLn E{PG, P.in[0], P.out, P.in[19], P.in[20], (unsigned long long*)(ws + OFF_STATS), (unsigned*)(ws + OFF_CTL + 16384), (unsigned*)(ws + OFF_CTL) + XB_TMO};
#pragma unroll 1
      for (int rnd = 0; rnd < 2; ++rnd) {
          pg8::Sched S{(const char*)A6, (const char*)W6, 0, 0, 1280, 1280, 128, 4, 1, 2, 0, 0, 4, 256, 256, 16, G, bid, 0}; S.ui0 = rnd; S.nui = 1;
          pg8::gemm_phase(lds, S, E);
      } }
}

extern "C" void kernel_launch(void* const* d_in, const int* in_sizes, int n_in, void* d_out, int out_size, void* d_ws, size_t ws_size, hipStream_t stream) {
    static int grid = 0;
    if (grid == 0) {
        if (n_in != 21 || out_size != T * 1024 || ws_size < WS_END) { fprintf(stderr, "kernel_launch: unexpected shapes: n_in %d out %d ws %zu (need %zu)\n", n_in, out_size, ws_size, (size_t)WS_END); grid = -1; return; }
        int dev = 0, cus = 0, per_cu = 0;
        (void)hipGetDevice(&dev); (void)hipDeviceGetAttribute(&cus, hipDeviceAttributeMultiprocessorCount, dev);
        if (hipFuncSetAttribute((const void*)mega, hipFuncAttributeMaxDynamicSharedMemorySize, LDS_BYTES) != hipSuccess) { fprintf(stderr, "kernel_launch: hipFuncSetAttribute failed\n"); grid = -1; return; }
        if (hipOccupancyMaxActiveBlocksPerMultiprocessor(&per_cu, (const void*)mega, NTHR, LDS_BYTES) != hipSuccess || per_cu < 1) { fprintf(stderr, "kernel_launch: occupancy query says %d\n", per_cu); per_cu = 1; }
        (void)hipGetLastError();
        grid = cus;
        if (grid != 256) { fprintf(stderr, "kernel_launch: this build needs a 256-CU device (got %d)\n", cus); grid = -1; return; }
    }
    if (grid < 0) return;
    if (hipMemsetAsync((char*)d_ws + OFF_CTL, 0, SZ_CTL, stream) != hipSuccess) { fprintf(stderr, "kernel_launch: memset failed\n"); return; }
    Params p{};
    for (int i = 0; i < 21; ++i) p.in[i] = (const float*)d_in[i];
    p.out = (float*)d_out; p.ws = (unsigned char*)d_ws;
    void* args[] = {&p};
    hipError_t e = hipLaunchCooperativeKernel((const void*)mega, dim3(grid), dim3(NTHR), args, LDS_BYTES, stream);
    if (e != hipSuccess) fprintf(stderr, "cooperative launch failed: %s (grid %d)\n", hipGetErrorString(e), grid);
}
```
